# Optimizing an MI355X kernel written in HIP

```python
import math
import jax, jax.numpy as jnp
from jax import lax
import numpy as np

D_MODEL = 1024
BATCH = 2
SEQ = 8192
DEPTH = 4

N_MIXERS = 3
N_META = 16
RMS_EPS = 1e-6
N_HEADS = 16
N_KV_HEADS = 4
HEAD_DIM = 64
GROUP = N_HEADS // N_KV_HEADS
WINDOW = 128
BLOCK = 128
N_BUCKETS = 32
MAX_DISTANCE = 128
CONV_WIDTH = 3
POOL_WINDOWS = (2, 4, 8, 16)
N_POOL_GROUPS = len(POOL_WINDOWS)
POOL_GROUP_DIM = D_MODEL // N_POOL_GROUPS
D_FF = ((8 * D_MODEL + 3 * 256 - 1) // (3 * 256)) * 256
N_ATTN = len(range(0, DEPTH, N_MIXERS))
N_CONV = len(range(1, DEPTH, N_MIXERS))
N_POOL = len(range(2, DEPTH, N_MIXERS))

kernel_name = "hybrid_swa_sink_shortconv_pool_decoder"


def rms_norm(x, g):
    xf = x.astype(jnp.float32)
    y = xf * lax.rsqrt(jnp.mean(xf * xf, axis=-1, keepdims=True) + RMS_EPS)
    return (y * g.astype(jnp.float32)).astype(x.dtype)


def rel_bucket(dist):
    max_exact = N_BUCKETS // 2
    d = jnp.maximum(dist, 0)
    df = jnp.maximum(d, 1).astype(jnp.float32)
    large = max_exact + (jnp.log(df / max_exact) / math.log(MAX_DISTANCE / max_exact)
                         * (N_BUCKETS - max_exact)).astype(jnp.int32)
    large = jnp.minimum(large, N_BUCKETS - 1)
    return jnp.where(d < max_exact, d, large)


def rel_bias(rel_table, dist):
    b = rel_table.astype(jnp.float32)[rel_bucket(dist)]
    return jnp.moveaxis(b, -1, 0)


def sliding_window_attention(h, w_qkv, b_qkv, w_o, b_o, sinks, rel_table):
    bsz, L, _ = h.shape
    S = L - N_META
    nb = S // BLOCK
    qkv = h @ w_qkv + b_qkv
    q, k, v = jnp.split(qkv, [N_HEADS * HEAD_DIM, (N_HEADS + N_KV_HEADS) * HEAD_DIM], axis=-1)
    q = q.reshape(bsz, L, N_KV_HEADS, GROUP, HEAD_DIM) * (HEAD_DIM ** -0.5)
    k = k.reshape(bsz, L, N_KV_HEADS, HEAD_DIM)
    v = v.reshape(bsz, L, N_KV_HEADS, HEAD_DIM)
    qm, qr = q[:, :N_META], q[:, N_META:]
    km, kr = k[:, :N_META], k[:, N_META:]
    vm, vr = v[:, :N_META], v[:, N_META:]
    sink = sinks.astype(jnp.float32).reshape(N_KV_HEADS, GROUP)

    im = jnp.arange(N_META)
    dist_mm = im[:, None] - im[None, :]
    s_mm = jnp.einsum('bqkgd,bmkd->bkgqm', qm, km).astype(jnp.float32)
    s_mm = s_mm + rel_bias(rel_table, dist_mm).reshape(N_KV_HEADS, GROUP, N_META, N_META)
    s_mm = jnp.where(dist_mm >= 0, s_mm, -jnp.inf)
    sink_mm = jnp.broadcast_to(sink[None, :, :, None, None], s_mm.shape[:-1] + (1,))
    p_mm = jax.nn.softmax(jnp.concatenate([s_mm, sink_mm], axis=-1), axis=-1)[..., :N_META]
    o_m = jnp.einsum('bkgqm,bmkd->bqkgd', p_mm.astype(v.dtype), vm)
    o_m = o_m.reshape(bsz, N_META, N_HEADS * HEAD_DIM)

    qb = qr.reshape(bsz, nb, BLOCK, N_KV_HEADS, GROUP, HEAD_DIM)
    kb = jnp.pad(kr, ((0, 0), (BLOCK, 0), (0, 0), (0, 0))).reshape(bsz, nb + 1, BLOCK, N_KV_HEADS, HEAD_DIM)
    vb = jnp.pad(vr, ((0, 0), (BLOCK, 0), (0, 0), (0, 0))).reshape(bsz, nb + 1, BLOCK, N_KV_HEADS, HEAD_DIM)
    k_band = jnp.concatenate([kb[:, :-1], kb[:, 1:]], axis=2)
    v_band = jnp.concatenate([vb[:, :-1], vb[:, 1:]], axis=2)

    iq = jnp.arange(BLOCK)[:, None]
    jk = jnp.arange(2 * BLOCK)[None, :]
    dist_band = BLOCK + iq - jk
    blk = jnp.arange(nb)[:, None, None]
    valid = (dist_band >= 0) & (dist_band < WINDOW) & ((blk > 0) | (jk >= BLOCK))
    bias_band = rel_bias(rel_table, dist_band).reshape(N_KV_HEADS, GROUP, BLOCK, 2 * BLOCK)

    qpos = N_META + jnp.arange(nb)[:, None] * BLOCK + jnp.arange(BLOCK)[None, :]
    dist_meta = qpos[:, :, None] - im[None, None, :]
    bias_meta = jnp.moveaxis(rel_bias(rel_table, dist_meta), 0, 1)
    bias_meta = bias_meta.reshape(nb, N_KV_HEADS, GROUP, BLOCK, N_META)

    s_band = jnp.einsum('bnqkgd,bnskd->bnkgqs', qb, k_band).astype(jnp.float32) + bias_band
    s_band = jnp.where(valid[None, :, None, None], s_band, -jnp.inf)
    s_meta = jnp.einsum('bnqkgd,bmkd->bnkgqm', qb, km).astype(jnp.float32) + bias_meta[None]
    sink_b = jnp.broadcast_to(sink[None, None, :, :, None, None], s_band.shape[:-1] + (1,))
    p = jax.nn.softmax(jnp.concatenate([s_meta, s_band, sink_b], axis=-1), axis=-1)
    p_meta = p[..., :N_META].astype(v.dtype)
    p_band = p[..., N_META:N_META + 2 * BLOCK].astype(v.dtype)
    o_r = (jnp.einsum('bnkgqm,bmkd->bnqkgd', p_meta, vm)
           + jnp.einsum('bnkgqs,bnskd->bnqkgd', p_band, v_band))
    o_r = o_r.reshape(bsz, S, N_HEADS * HEAD_DIM)

    o = jnp.concatenate([o_m, o_r], axis=1)
    return o @ w_o + b_o


def short_conv_mixer(h, w_in, conv_w, w_out):
    L = h.shape[1]
    gate_b, gate_c, u = jnp.split(h @ w_in, 3, axis=-1)
    z = gate_c * u
    zp = jnp.pad(z, ((0, 0), (CONV_WIDTH - 1, 0), (0, 0)))
    conv = sum(conv_w[t] * zp[:, t:t + L] for t in range(CONV_WIDTH))
    return (gate_b * conv) @ w_out


def pooling_mixer(h, w_pool, scale):
    bsz, L, D = h.shape
    hf = h.astype(jnp.float32).reshape(bsz, L, N_POOL_GROUPS, POOL_GROUP_DIM)
    cs = jnp.pad(lax.cumsum(hf, axis=1), ((0, 0), (1, 0), (0, 0), (0, 0)))
    t = jnp.arange(L)[:, None]
    win = jnp.array(POOL_WINDOWS, dtype=jnp.int32)[None, :]
    lo = jnp.maximum(t + 1 - win, 0)
    count = jnp.minimum(win, t + 1).astype(jnp.float32)
    lower = cs[:, lo, jnp.arange(N_POOL_GROUPS)[None, :], :]
    mix = (cs[:, 1:] - lower) / count[None, :, :, None] - hf
    out = jnp.einsum('blgc,gcd->blgd', mix.astype(h.dtype), w_pool).reshape(bsz, L, D)
    return out * scale


def swiglu(h, w_gate, w_up, w_down):
    return (jax.nn.silu(h @ w_gate) * (h @ w_up)) @ w_down


def setup_inputs(seed: int = 0) -> dict:
    key = jax.random.key(seed)
    ks = jax.random.split(key, 20)
    f32 = jnp.float32
    qkv_out = (N_HEADS + 2 * N_KV_HEADS) * HEAD_DIM
    nrm = lambda k, shape, s: jax.random.normal(k, shape, f32) * s
    return {
        "x": nrm(ks[0], (BATCH, SEQ, D_MODEL), 1.0),
        "meta_tokens": nrm(ks[1], (N_META, D_MODEL), 1.0),
        "rel_bias_table": nrm(ks[2], (N_BUCKETS, N_HEADS), 0.5),
        "norm_mix": 1.0 + nrm(ks[3], (DEPTH, D_MODEL), 0.02),
        "norm_ffn": 1.0 + nrm(ks[4], (DEPTH, D_MODEL), 0.02),
        "norm_final": 1.0 + nrm(ks[5], (D_MODEL,), 0.02),
        "attn_w_qkv": nrm(ks[6], (N_ATTN, D_MODEL, qkv_out), D_MODEL ** -0.5),
        "attn_b_qkv": nrm(ks[7], (N_ATTN, qkv_out), 0.02),
        "attn_w_o": nrm(ks[8], (N_ATTN, N_HEADS * HEAD_DIM, D_MODEL), (N_HEADS * HEAD_DIM) ** -0.5),
        "attn_b_o": nrm(ks[9], (N_ATTN, D_MODEL), 0.02),
        "attn_sinks": nrm(ks[10], (N_ATTN, N_HEADS), 1.0),
        "conv_w_in": nrm(ks[11], (N_CONV, D_MODEL, 3 * D_MODEL), D_MODEL ** -0.5),
        "conv_w": nrm(ks[12], (N_CONV, CONV_WIDTH, D_MODEL), CONV_WIDTH ** -0.5),
        "conv_w_out": nrm(ks[13], (N_CONV, D_MODEL, D_MODEL), D_MODEL ** -0.5),
        "pool_w": nrm(ks[14], (N_POOL, N_POOL_GROUPS, POOL_GROUP_DIM, POOL_GROUP_DIM), POOL_GROUP_DIM ** -0.5),
        "pool_scale": 1.0 + nrm(ks[15], (N_POOL, D_MODEL), 0.1),
        "ffn_w_gate": nrm(ks[16], (DEPTH, D_MODEL, D_FF), D_MODEL ** -0.5),
        "ffn_w_up": nrm(ks[17], (DEPTH, D_MODEL, D_FF), D_MODEL ** -0.5),
        "ffn_w_down": nrm(ks[18], (DEPTH, D_FF, D_MODEL), D_FF ** -0.5),
    }


def reference(x, meta_tokens, rel_bias_table, norm_mix, norm_ffn, norm_final,
              attn_w_qkv, attn_b_qkv, attn_w_o, attn_b_o, attn_sinks,
              conv_w_in, conv_w, conv_w_out,
              pool_w, pool_scale,
              ffn_w_gate, ffn_w_up, ffn_w_down):
    bsz = x.shape[0]
    meta = jnp.broadcast_to(meta_tokens.astype(x.dtype)[None], (bsz, N_META, D_MODEL))
    h = jnp.concatenate([meta, x], axis=1)
    for i in range(DEPTH):
        kind, j = i % N_MIXERS, i // N_MIXERS
        a = rms_norm(h, norm_mix[i])
        if kind == 0:
            m = sliding_window_attention(a, attn_w_qkv[j], attn_b_qkv[j], attn_w_o[j], attn_b_o[j],
                                         attn_sinks[j], rel_bias_table)
        elif kind == 1:
            m = short_conv_mixer(a, conv_w_in[j], conv_w[j], conv_w_out[j])
        else:
            m = pooling_mixer(a, pool_w[j], pool_scale[j])
        h = h + m.astype(h.dtype)
        h = h + swiglu(rms_norm(h, norm_ffn[i]), ffn_w_gate[i], ffn_w_up[i], ffn_w_down[i])
    h = rms_norm(h, norm_final)
    return h[:, N_META:]
```

```cpp
#include <hip/hip_runtime.h>
#include <math.h>

namespace nv {
constexpr int D = 1024, NB = 2, S = 8192, NMETA = 16, MR = NB * S, MT = MR + NB * NMETA;
constexpr int H = 16, HD = 64, NQKV = 1536, FF = 2816, FFC = 704;
constexpr float EPS = 1e-6f;

__device__ __forceinline__ int rowof(int b, int t) { return t < NMETA ? MR + b * NMETA + t : b * S + (t - NMETA); }
__device__ __forceinline__ void bt_of(int r, int& b, int& t) { if (r < MR) { b = r / S; t = NMETA + (r % S); } else { b = (r - MR) / NMETA; t = (r - MR) % NMETA; } }
struct HPtr { float* real; float* meta; __device__ __forceinline__ float* row(int r) const { return r < MR ? real + (size_t)r * D : meta + (size_t)(r - MR) * D; } };

__device__ __forceinline__ int bucket(int dist) {
    if (dist < 16) return dist < 0 ? 0 : dist;
    int v = 16 + (int)(log2f((float)dist * 0.0625f) * (16.0f / 3.0f));
    return v > 31 ? 31 : v;
}

__global__ __launch_bounds__(256) void init_h(const float* x, const float* meta, HPtr h) {
    const int r = blockIdx.x; const float* src = r < MR ? x + (size_t)r * D : meta + (size_t)((r - MR) % NMETA) * D;
    float4 v = ((const float4*)src)[threadIdx.x]; ((float4*)h.row(r))[threadIdx.x] = v;
}

__device__ __forceinline__ float block_sum256(float v, float* red) {
    for (int o = 32; o > 0; o >>= 1) v += __shfl_xor(v, o);
    __syncthreads();
    if ((threadIdx.x & 63) == 0) red[threadIdx.x >> 6] = v;
    __syncthreads();
    return red[0] + red[1] + red[2] + red[3];
}

__global__ __launch_bounds__(256) void rmsnorm_k(HPtr h, const float* g, float* a) {
    __shared__ float red[4];
    const int r = blockIdx.x; float4 v = ((const float4*)h.row(r))[threadIdx.x];
    float ss = block_sum256(v.x * v.x + v.y * v.y + v.z * v.z + v.w * v.w, red);
    const float rs = 1.0f / sqrtf(ss * (1.0f / D) + EPS);
    float4 gg = ((const float4*)g)[threadIdx.x];
    float4 o; o.x = v.x * rs * gg.x; o.y = v.y * rs * gg.y; o.z = v.z * rs * gg.z; o.w = v.w * rs * gg.w;
    ((float4*)(a + (size_t)r * D))[threadIdx.x] = o;
}

__global__ __launch_bounds__(256) void final_k(const float* hreal, const float* g, float* out) {
    __shared__ float red[4];
    const int r = blockIdx.x; float4 v = ((const float4*)(hreal + (size_t)r * D))[threadIdx.x];
    float ss = block_sum256(v.x * v.x + v.y * v.y + v.z * v.z + v.w * v.w, red);
    const float rs = 1.0f / sqrtf(ss * (1.0f / D) + EPS);
    float4 gg = ((const float4*)g)[threadIdx.x];
    float4 o; o.x = v.x * rs * gg.x; o.y = v.y * rs * gg.y; o.z = v.z * rs * gg.z; o.w = v.w * rs * gg.w;
    ((float4*)(out + (size_t)r * D))[threadIdx.x] = o;
}

template <int MODE>
__global__ __launch_bounds__(256) void gemm_k(const float* A, int lda, const float* W, int ldw, int M, int N, int K,
                                              float* C, int ldc, HPtr h, int hcol0, const float* bias, const float* scale) {
    __shared__ float As[16][68];
    __shared__ float Ws[16][68];
    const int tid = threadIdx.x, tx = tid & 15, ty = tid >> 4;
    const int row0 = blockIdx.y * 64, col0 = blockIdx.x * 64;
    float acc[4][4];
#pragma unroll
    for (int i = 0; i < 4; ++i)
#pragma unroll
        for (int j = 0; j < 4; ++j) acc[i][j] = 0.f;
    const int ar = tid >> 2, ak = (tid & 3) * 4;
    const int wk = tid >> 4, wn = (tid & 15) * 4;
    for (int k0 = 0; k0 < K; k0 += 16) {
        float4 av = make_float4(0.f, 0.f, 0.f, 0.f);
        if (row0 + ar < M) av = *(const float4*)(A + (size_t)(row0 + ar) * lda + k0 + ak);
        float4 wv = *(const float4*)(W + (size_t)(k0 + wk) * ldw + col0 + wn);
        __syncthreads();
        As[ak + 0][ar] = av.x; As[ak + 1][ar] = av.y; As[ak + 2][ar] = av.z; As[ak + 3][ar] = av.w;
        *(float4*)&Ws[wk][wn] = wv;
        __syncthreads();
#pragma unroll
        for (int kk = 0; kk < 16; ++kk) {
            float4 a4 = *(const float4*)&As[kk][ty * 4];
            float4 w4 = *(const float4*)&Ws[kk][tx * 4];
            const float aa[4] = {a4.x, a4.y, a4.z, a4.w}, ww[4] = {w4.x, w4.y, w4.z, w4.w};
#pragma unroll
            for (int i = 0; i < 4; ++i)
#pragma unroll
                for (int j = 0; j < 4; ++j) acc[i][j] += aa[i] * ww[j];
        }
    }
#pragma unroll
    for (int i = 0; i < 4; ++i) {
        const int row = row0 + ty * 4 + i; if (row >= M) continue;
#pragma unroll
        for (int j = 0; j < 4; ++j) {
            const int col = col0 + tx * 4 + j;
            float v = acc[i][j] + (bias ? bias[col] : 0.f);
            if (MODE == 0) C[(size_t)row * ldc + col] = v;
            else { float* p = h.row(row) + hcol0 + col; *p = *p + v * (scale ? scale[col] : 1.f); }
        }
    }
}

__global__ __launch_bounds__(64) void attn_k(const float* qkv, const float* table, const float* sinks, float* o) {
    const int r = blockIdx.x, hd = blockIdx.y, lane = threadIdx.x, kvh = hd >> 2;
    __shared__ float qs[64]; __shared__ float ps[192]; __shared__ int krow[192];
    int b, t; bt_of(r, b, t);
    qs[lane] = qkv[(size_t)r * NQKV + hd * 64 + lane] * 0.125f;
    int nk, lo = 0; const int s = t - NMETA;
    if (r < MR) { lo = s - 127 > 0 ? s - 127 : 0; nk = 16 + (s - lo + 1); } else nk = t + 1;
    __syncthreads();
    const float sink = sinks[hd];
    float sc[3]; float mx = sink;
    for (int i = 0; i < 3; ++i) {
        const int k = lane + 64 * i; sc[i] = -INFINITY;
        if (k < nk) {
            int kr, dist;
            if (r < MR) { if (k < 16) { kr = MR + b * 16 + k; dist = t - k; } else { const int s2 = lo + (k - 16); kr = b * S + s2; dist = s - s2; } }
            else { kr = MR + b * 16 + k; dist = t - k; }
            const float* kp = qkv + (size_t)kr * NQKV + 1024 + kvh * 64; float d = 0.f;
            for (int e = 0; e < 64; ++e) d += qs[e] * kp[e];
            sc[i] = d + table[bucket(dist) * 16 + hd]; krow[k] = kr; mx = fmaxf(mx, sc[i]);
        }
    }
    for (int o2 = 32; o2 > 0; o2 >>= 1) mx = fmaxf(mx, __shfl_xor(mx, o2));
    float sum = 0.f;
    for (int i = 0; i < 3; ++i) { const int k = lane + 64 * i; if (k < nk) { const float p = expf(sc[i] - mx); ps[k] = p; sum += p; } }
    for (int o2 = 32; o2 > 0; o2 >>= 1) sum += __shfl_xor(sum, o2);
    sum += expf(sink - mx);
    __syncthreads();
    float acc = 0.f;
    for (int k = 0; k < nk; ++k) acc += ps[k] * qkv[(size_t)krow[k] * NQKV + 1280 + kvh * 64 + lane];
    o[(size_t)r * D + hd * 64 + lane] = acc / sum;
}

__global__ void swiglu_k(float* g, const float* u, size_t n) {
    size_t i = (size_t)blockIdx.x * blockDim.x + threadIdx.x; if (i >= n) return;
    const float x = g[i]; g[i] = x / (1.0f + expf(-x)) * u[i];
}
__global__ void mul_k(float* a, const float* b, size_t n) {
    size_t i = (size_t)blockIdx.x * blockDim.x + threadIdx.x; if (i >= n) return; a[i] *= b[i];
}
__global__ __launch_bounds__(256) void conv_k(float* gb, const float* z, const float* cw) {
    const int r = blockIdx.x; int b, t; bt_of(r, b, t);
    for (int c = threadIdx.x; c < D; c += 256) {
        float acc = cw[2 * D + c] * z[(size_t)r * D + c];
        if (t >= 1) acc += cw[1 * D + c] * z[(size_t)rowof(b, t - 1) * D + c];
        if (t >= 2) acc += cw[0 * D + c] * z[(size_t)rowof(b, t - 2) * D + c];
        gb[(size_t)r * D + c] *= acc;
    }
}
__global__ __launch_bounds__(256) void pool_k(const float* a, float* mix) {
    const int r = blockIdx.x; int b, t; bt_of(r, b, t);
    for (int c = threadIdx.x; c < D; c += 256) {
        const int gi = c >> 8, win = 2 << gi, cnt = win < t + 1 ? win : t + 1;
        float sacc = 0.f;
        for (int j = 0; j < cnt; ++j) sacc += a[(size_t)rowof(b, t - j) * D + c];
        mix[(size_t)r * D + c] = sacc / (float)cnt - a[(size_t)r * D + c];
    }
}
}

extern "C" void kernel_launch(void* const* d_in, const int* in_sizes, int n_in, void* d_out, int out_size, void* d_ws, size_t ws_size, hipStream_t stream) {
    using namespace nv;
    const float* x = (const float*)d_in[0]; const float* meta = (const float*)d_in[1]; const float* table = (const float*)d_in[2];
    const float* norm_mix = (const float*)d_in[3]; const float* norm_ffn = (const float*)d_in[4]; const float* norm_final = (const float*)d_in[5];
    const float* wqkv = (const float*)d_in[6]; const float* bqkv = (const float*)d_in[7]; const float* wo = (const float*)d_in[8]; const float* bo = (const float*)d_in[9];
    const float* sinks = (const float*)d_in[10]; const float* w_in = (const float*)d_in[11]; const float* conv_w = (const float*)d_in[12]; const float* w_out = (const float*)d_in[13];
    const float* pool_w = (const float*)d_in[14]; const float* pool_scale = (const float*)d_in[15];
    const float* wg = (const float*)d_in[16]; const float* wu = (const float*)d_in[17]; const float* wd = (const float*)d_in[18];
    char* ws = (char*)d_ws;
    float* hmeta = (float*)ws;
    float* a = (float*)(ws + (1u << 20));
    const size_t abytes = (size_t)MT * D * 4;
    float* R3a = (float*)(ws + (1u << 20) + abytes);
    float* R3b = R3a + (size_t)MT * D;
    HPtr h{(float*)d_out, hmeta};
    HPtr hnull{nullptr, nullptr};
    const dim3 b256(256);
    auto gemm0 = [&](const float* A, int lda, const float* W, int ldw, int N, int K, float* C, int ldc, const float* bias) {
        hipLaunchKernelGGL(gemm_k<0>, dim3(N / 64, (MT + 63) / 64), b256, 0, stream, A, lda, W, ldw, MT, N, K, C, ldc, hnull, 0, bias, (const float*)nullptr);
    };
    auto gemm1 = [&](const float* A, int lda, const float* W, int ldw, int N, int K, int hcol0, const float* bias, const float* scale) {
        hipLaunchKernelGGL(gemm_k<1>, dim3(N / 64, (MT + 63) / 64), b256, 0, stream, A, lda, W, ldw, MT, N, K, (float*)nullptr, 0, h, hcol0, bias, scale);
    };
    hipLaunchKernelGGL(init_h, dim3(MT), b256, 0, stream, x, meta, h);
    for (int i = 0; i < 4; ++i) {
        const int kind = i % 3, j = i / 3;
        hipLaunchKernelGGL(rmsnorm_k, dim3(MT), b256, 0, stream, h, norm_mix + (size_t)i * D, a);
        if (kind == 0) {
            gemm0(a, D, wqkv + (size_t)j * D * NQKV, NQKV, NQKV, D, R3a, NQKV, bqkv + (size_t)j * NQKV);
            hipLaunchKernelGGL(attn_k, dim3(MT, H), dim3(64), 0, stream, (const float*)R3a, table, sinks + (size_t)j * H, a);
            gemm1(a, D, wo + (size_t)j * D * D, D, D, D, 0, bo + (size_t)j * D, nullptr);
        } else if (kind == 1) {
            const float* win = w_in + (size_t)j * D * 3 * D;
            gemm0(a, D, win + D, 3 * D, D, D, R3a, D, nullptr);
            gemm0(a, D, win + 2 * D, 3 * D, D, D, R3b, D, nullptr);
            const size_t n = (size_t)MT * D;
            hipLaunchKernelGGL(mul_k, dim3((unsigned)((n + 255) / 256)), b256, 0, stream, R3a, (const float*)R3b, n);
            gemm0(a, D, win, 3 * D, D, D, R3b, D, nullptr);
            hipLaunchKernelGGL(conv_k, dim3(MT), b256, 0, stream, R3b, (const float*)R3a, conv_w + (size_t)j * 3 * D);
            gemm1(R3b, D, w_out + (size_t)j * D * D, D, D, D, 0, nullptr, nullptr);
        } else {
            hipLaunchKernelGGL(pool_k, dim3(MT), b256, 0, stream, (const float*)a, R3a);
            for (int gi = 0; gi < 4; ++gi)
                gemm1(R3a + gi * 256, D, pool_w + (size_t)j * 4 * 256 * 256 + (size_t)gi * 256 * 256, 256, 256, 256, gi * 256, nullptr, pool_scale + (size_t)j * D + gi * 256);
        }
        hipLaunchKernelGGL(rmsnorm_k, dim3(MT), b256, 0, stream, h, norm_ffn + (size_t)i * D, a);
        for (int c = 0; c < FF / FFC; ++c) {
            gemm0(a, D, wg + (size_t)i * D * FF + c * FFC, FF, FFC, D, R3a, FFC, nullptr);
            gemm0(a, D, wu + (size_t)i * D * FF + c * FFC, FF, FFC, D, R3b, FFC, nullptr);
            const size_t n = (size_t)MT * FFC;
            hipLaunchKernelGGL(swiglu_k, dim3((unsigned)((n + 255) / 256)), b256, 0, stream, R3a, (const float*)R3b, n);
            gemm1(R3a, FFC, wd + (size_t)i * FF * D + (size_t)c * FFC * D, D, D, FFC, 0, nullptr, nullptr);
        }
    }
    hipLaunchKernelGGL(final_k, dim3(MR), b256, 0, stream, (const float*)d_out, norm_final, (float*)d_out);
}
```

```cpp
#include <hip/hip_runtime.h>
#include <cstdio>
#include <cstdint>

#ifndef MK_N_LAUNCHES
#define MK_N_LAUNCHES 21
#endif

#define LAS __attribute__((address_space(3)))
#define GAS __attribute__((address_space(1)))
typedef unsigned short bf16_t;
typedef short bf16x8 __attribute__((ext_vector_type(8)));
typedef short s16x4 __attribute__((ext_vector_type(4)));
typedef float f32x2 __attribute__((ext_vector_type(2)));
typedef float f32x4 __attribute__((ext_vector_type(4)));
typedef float f32x16 __attribute__((ext_vector_type(16)));
typedef unsigned u32x2 __attribute__((ext_vector_type(2)));
typedef unsigned u32x4 __attribute__((ext_vector_type(4)));
typedef __bf16 bf16x2_t __attribute__((ext_vector_type(2)));

constexpr int D = 1024, NB = 2, S = 8192, NMETA = 16, LSEQ = S + NMETA;
constexpr int MR = NB * S;
constexpr int MT = MR + NB * NMETA;
constexpr int MP = 65 * 256;
constexpr int NH = 16, NKV = 4, HD = 64, NQKV = 1536, FF = 2816;
constexpr float EPS = 1e-6f;
constexpr float LOG2E = 1.4426950408889634f;
constexpr float QSCALE = 0.125f * LOG2E;
constexpr int NWAVES = 8, NTHR = 512;

constexpr size_t MiB = 1u << 20;
constexpr size_t WS_CTL = 0, CTL_ZERO_BYTES = 1 * MiB;
constexpr size_t WS_HMETA = 1 * MiB;
constexpr size_t WS_SSQ = 2 * MiB;
constexpr size_t WS_TB = 4 * MiB;
constexpr size_t WS_W = 5 * MiB;
constexpr size_t W_QKV = 0, W_O = 3 * MiB, W_ATT_STRIDE = 5 * MiB;
constexpr size_t W_CIN = 10 * MiB, W_COUT = 16 * MiB, W_POOL = 18 * MiB;
constexpr size_t W_FFN = 19 * MiB, W_FFN_STRIDE = 33 * MiB / 2, W_GU = 0, W_DN = 11 * MiB;
constexpr size_t WS_HB = 90 * MiB;
constexpr size_t WS_BIG = 123 * MiB;
constexpr size_t BIG_QKV = 0, BIG_O = 49 * MiB;
constexpr size_t BIG_GB = 0, BIG_Z = 33 * MiB, BIG_G = 66 * MiB;
constexpr size_t WS_END = 256 * MiB;
static_assert(W_FFN + 4 * W_FFN_STRIDE <= 85 * MiB && WS_W + 85 * MiB <= WS_HB, "weights");
static_assert(WS_HB + (size_t)MP * D * 2 <= WS_BIG && WS_BIG + (size_t)MP * FF * 2 <= WS_END, "ws map");

constexpr int CW_BAR = 4096;

constexpr int RING_BYTES = 131072;
constexpr int LDSCTL_OFF = RING_BYTES, MISC_OFF = LDSCTL_OFF + 320;
constexpr int LDS_BYTES = 147456;

__device__ __forceinline__ unsigned cvtpk(float lo, float hi) { f32x2 v = {lo, hi}; bf16x2_t b = __builtin_convertvector(v, bf16x2_t); return __builtin_bit_cast(unsigned, b); }
__device__ __forceinline__ float bf2f(unsigned short u) { return __builtin_bit_cast(float, (unsigned)u << 16); }
__device__ __forceinline__ float wave_sum(float v) {
#pragma unroll
    for (int o = 1; o < 64; o <<= 1) v += __shfl_xor(v, o);
    return v;
}
__device__ __forceinline__ int rowof(int b, int t) { return t < NMETA ? MR + b * NMETA + t : b * S + (t - NMETA); }
__device__ __forceinline__ int bucket_of(int dist) {
    if (dist < 16) return dist < 0 ? 0 : dist;
    int v = 16 + (int)(log2f((float)dist * 0.0625f) * (16.0f / 3.0f));
    return v > 31 ? 31 : v;
}
#define LDS_WAIT() asm volatile("s_waitcnt lgkmcnt(0)" ::: "memory")
#define VM_WAIT() asm volatile("s_waitcnt vmcnt(0)" ::: "memory")

namespace pg8 {
constexpr int BM = 256, BK = 64, HALF = 128, HTB = HALF * BK * 2, STAGE_BYTES = 8 * HTB, NXCD = 8, WGM = 8;
__host__ __device__ __forceinline__ int lds_byte(int r, int c) { const int st = (r >> 4) * 2 + (c >> 5), rr = r & 15, cc = c & 31, ob = rr * 64 + cc * 2; return st * 1024 + (ob ^ (((ob >> 9) & 1) << 5)); }
__host__ __device__ __forceinline__ void stage_rc(int b, int& R, int& C) { const int st = b / 1024, sb = b % 1024, swz = sb ^ (((sb >> 9) & 1) << 5); R = (st >> 1) * 16 + swz / 64; C = (st & 1) * 32 + (swz % 64) / 2; }
__host__ __device__ __forceinline__ int perm32(int rho) { const int n = rho >> 4, i = rho & 15; return 8 * (i >> 2) + 4 * n + (i & 3); }

struct Unit { int pm, pn; };
struct Gemm { const bf16_t* A; const bf16_t* Bt; int lda, ldb, K, a_pn_off; };

struct StaticOrder {
    int nM, nN, nwg, G, c;
    __device__ void init(int nM_, int nN_, int G_, int c_) { nM = nM_; nN = nN_; nwg = nM * nN; G = G_; c = c_; }
    __device__ bool next(int i, Unit& u) const {
        const long L = (long)i * G + c; if (L >= nwg) return false;
        int wgid = (int)L; { const int q = nwg / NXCD, r = nwg % NXCD, xcd = wgid % NXCD, off = wgid / NXCD; wgid = (xcd < r ? xcd * (q + 1) : r * (q + 1) + (xcd - r) * q) + off; }
        const int nig = WGM * nN, gid = wgid / nig, fm = gid * WGM, gsz = (nM - fm) < WGM ? (nM - fm) : WGM;
        u.pm = fm + ((wgid % nig) % gsz); u.pn = (wgid % nig) / gsz; return true;
    }
};

__device__ __forceinline__ float rstd_of(const float* ssq, int row) {
    const f32x4* p = (const f32x4*)(ssq + (size_t)row * 16);
    const f32x4 a = p[0], b = p[1], c = p[2], d = p[3];
    const float s = ((a[0] + a[1]) + (a[2] + a[3])) + ((b[0] + b[1]) + (b[2] + b[3])) + ((c[0] + c[1]) + (c[2] + c[3])) + ((d[0] + d[1]) + (d[2] + d[3]));
    return __builtin_amdgcn_rsqf(s * (1.0f / D) + EPS);
}

struct EpiQKV {
    static constexpr bool PERM = true;
    bf16_t* O; const float* bias; const float* ssq;
    __device__ __forceinline__ void operator()(const f32x4 (&acc)[2][2][4][2], const Unit& u, int wr, int wc, int fr, int fq) const {
        const int row0 = u.pm * BM + wr * 64 + fr, col0 = u.pn * BM + wc * 32 + 8 * fq;
        const float sc = u.pn < 4 ? QSCALE : 1.0f;
        f32x4 bv[2][2];
#pragma unroll
        for (int bj = 0; bj < 2; ++bj)
#pragma unroll
            for (int n = 0; n < 2; ++n) bv[bj][n] = *(const f32x4*)(bias + col0 + bj * HALF + 4 * n);
#pragma unroll
        for (int ai = 0; ai < 2; ++ai)
#pragma unroll
            for (int m = 0; m < 4; ++m) {
                const int row = row0 + ai * HALF + m * 16; const float rs = rstd_of(ssq, row);
                bf16_t* rowp = O + (size_t)row * NQKV + col0;
#pragma unroll
                for (int bj = 0; bj < 2; ++bj) {
                    const f32x4 v0 = (acc[ai][bj][m][0] * rs + bv[bj][0]) * sc, v1 = (acc[ai][bj][m][1] * rs + bv[bj][1]) * sc;
                    u32x4 w; w.x = cvtpk(v0[0], v0[1]); w.y = cvtpk(v0[2], v0[3]); w.z = cvtpk(v1[0], v1[1]); w.w = cvtpk(v1[2], v1[3]);
                    *(u32x4*)(rowp + bj * HALF) = w;
                }
            }
    }
};
__device__ __forceinline__ float silu_mul(float g, float u) { return g * __builtin_amdgcn_rcpf(1.0f + __builtin_amdgcn_exp2f(-g * LOG2E)) * u; }
struct EpiSwiGLU {
    static constexpr bool PERM = true;
    bf16_t* O; const float* ssq;
    __device__ __forceinline__ void operator()(const f32x4 (&acc)[2][2][4][2], const Unit& u, int wr, int wc, int fr, int fq) const {
        const int row0 = u.pm * BM + wr * 64 + fr, col0 = u.pn * HALF + wc * 32 + 8 * fq;
#pragma unroll
        for (int ai = 0; ai < 2; ++ai)
#pragma unroll
            for (int m = 0; m < 4; ++m) {
                const int row = row0 + ai * HALF + m * 16; const float rs = rstd_of(ssq, row);
                const f32x4 g0 = acc[ai][0][m][0] * rs, g1 = acc[ai][0][m][1] * rs, u0 = acc[ai][1][m][0] * rs, u1 = acc[ai][1][m][1] * rs;
                u32x4 w; w.x = cvtpk(silu_mul(g0[0], u0[0]), silu_mul(g0[1], u0[1])); w.y = cvtpk(silu_mul(g0[2], u0[2]), silu_mul(g0[3], u0[3]));
                w.z = cvtpk(silu_mul(g1[0], u1[0]), silu_mul(g1[1], u1[1])); w.w = cvtpk(silu_mul(g1[2], u1[2]), silu_mul(g1[3], u1[3]));
                *(u32x4*)(O + (size_t)row * FF + col0) = w;
            }
    }
};
struct EpiConvIn {
    static constexpr bool PERM = true;
    bf16_t* GB; bf16_t* Z; const float* ssq;
    __device__ __forceinline__ void operator()(const f32x4 (&acc)[2][2][4][2], const Unit& u, int wr, int wc, int fr, int fq) const {
        const int row0 = u.pm * BM + wr * 64 + fr;
        if (u.pn < 4) {
            const int col0 = u.pn * BM + wc * 32 + 8 * fq;
#pragma unroll
            for (int ai = 0; ai < 2; ++ai)
#pragma unroll
                for (int m = 0; m < 4; ++m) {
                    const int row = row0 + ai * HALF + m * 16; const float rs = rstd_of(ssq, row);
                    bf16_t* rowp = GB + (size_t)row * D + col0;
#pragma unroll
                    for (int bj = 0; bj < 2; ++bj) {
                        const f32x4 v0 = acc[ai][bj][m][0] * rs, v1 = acc[ai][bj][m][1] * rs;
                        u32x4 w; w.x = cvtpk(v0[0], v0[1]); w.y = cvtpk(v0[2], v0[3]); w.z = cvtpk(v1[0], v1[1]); w.w = cvtpk(v1[2], v1[3]);
                        *(u32x4*)(rowp + bj * HALF) = w;
                    }
                }
        } else {
            const int col0 = (u.pn - 4) * HALF + wc * 32 + 8 * fq;
#pragma unroll
            for (int ai = 0; ai < 2; ++ai)
#pragma unroll
                for (int m = 0; m < 4; ++m) {
                    const int row = row0 + ai * HALF + m * 16; const float rs = rstd_of(ssq, row); const float r2 = rs * rs;
                    const f32x4 z0 = acc[ai][0][m][0] * acc[ai][1][m][0] * r2, z1 = acc[ai][0][m][1] * acc[ai][1][m][1] * r2;
                    u32x4 w; w.x = cvtpk(z0[0], z0[1]); w.y = cvtpk(z0[2], z0[3]); w.z = cvtpk(z1[0], z1[1]); w.w = cvtpk(z1[2], z1[3]);
                    *(u32x4*)(Z + (size_t)row * D + col0) = w;
                }
        }
    }
};
struct EpiResid {
    static constexpr bool PERM = false;
    const float* base_real; const float* base_meta; float* out_real; float* out_meta; bf16_t* HB; float* ssq; const float* bias; const float* cscale;
    __device__ __forceinline__ void operator()(const f32x4 (&acc)[2][2][4][2], const Unit& u, int wr, int wc, int fr, int fq) const {
        const int col0 = u.pn * BM + wc * 32 + 4 * fq;
        const bool meta = u.pm >= 64;
        const float* base = meta ? base_meta - (size_t)MR * D : base_real;
        float* out = meta ? out_meta - (size_t)MR * D : out_real;
        f32x4 bv[2][2], cs[2][2];
#pragma unroll
        for (int bj = 0; bj < 2; ++bj)
#pragma unroll
            for (int n = 0; n < 2; ++n) {
                bv[bj][n] = bias ? *(const f32x4*)(bias + col0 + bj * HALF + n * 16) : (f32x4){0.f, 0.f, 0.f, 0.f};
                cs[bj][n] = cscale ? *(const f32x4*)(cscale + col0 + bj * HALF + n * 16) : (f32x4){1.f, 1.f, 1.f, 1.f};
            }
#pragma unroll
        for (int ai = 0; ai < 2; ++ai)
#pragma unroll
            for (int m = 0; m < 4; ++m) {
                const int row = u.pm * BM + ai * HALF + wr * 64 + m * 16 + fr; const size_t off = (size_t)row * D + col0;
                float q = 0.f;
#pragma unroll
                for (int bj = 0; bj < 2; ++bj)
#pragma unroll
                    for (int n = 0; n < 2; ++n) {
                        const f32x4 bs = *(const f32x4*)(base + off + bj * HALF + n * 16);
                        const f32x4 v = bs + (acc[ai][bj][m][n] + bv[bj][n]) * cs[bj][n];
                        *(f32x4*)(out + off + bj * HALF + n * 16) = v;
                        u32x2 w; w.x = cvtpk(v[0], v[1]); w.y = cvtpk(v[2], v[3]);
                        *(u32x2*)(HB + off + bj * HALF + n * 16) = w;
                        q += (v[0] * v[0] + v[1] * v[1]) + (v[2] * v[2] + v[3] * v[3]);
                    }
                q += __shfl_xor(q, 16); q += __shfl_xor(q, 32);
                if (fq == 0) ssq[(size_t)row * 16 + u.pn * 4 + wc] = q;
            }
    }
};

template <class Epi>
__device__ __forceinline__ void gemm_phase(LAS unsigned char* lds, const Gemm g, const StaticOrder& S, const Epi& E, const int tid) {
    const int wid = __builtin_amdgcn_readfirstlane(tid >> 6), lane = tid & 63, wr = wid >> 2, wc = wid & 3, fr = lane & 15, fq = lane >> 4;
    const int K = g.K, nt = K / BK;
    unsigned voffA[2], voffB[2];
#pragma unroll
    for (int i = 0; i < 2; ++i) { int R, C; stage_rc(tid * 16 + i * 8192, R, C); const int Rb = Epi::PERM ? ((R & ~31) + perm32(R & 31)) : R;
        voffA[i] = (unsigned)(R * g.lda + C) * 2u; voffB[i] = (unsigned)(Rb * g.ldb + C) * 2u; }
    const size_t kstep = (size_t)(BK * 2);
    const size_t hstepA = (size_t)HALF * g.lda * 2, hstepB = (size_t)HALF * g.ldb * 2;
    const size_t tstepA = 2 * hstepA, tstepB = 2 * hstepB;
    const size_t pnoffA = (size_t)g.a_pn_off * 2;
    const unsigned ldsw = (unsigned)wid * 1024u;
    const int aoff = lds_byte(wr * 64 + fr, fq * 8), boff = lds_byte(wc * 32 + fr, fq * 8);
#define PG8_SA(b, h) (((b) * 2 + (h)) * HTB)
#define PG8_SB(b, h) ((4 + (b) * 2 + (h)) * HTB)
#define PG8_STAGE(bufoff, gbase, voff) do { _Pragma("unroll") for (int _i = 0; _i < 2; ++_i) \
        __builtin_amdgcn_global_load_lds((const unsigned*)((const char*)(gbase) + (voff)[_i]), (LAS unsigned*)(lds + (bufoff) + ldsw + _i * 8192), 16, 0, 0); } while (0)
#define PG8_LDA(dst, b, h) do { _Pragma("unroll") for (int m = 0; m < 4; ++m) _Pragma("unroll") for (int k = 0; k < 2; ++k) dst[m][k] = *(const LAS bf16x8*)(lds + PG8_SA(b, h) + aoff + m * 2048 + k * 1024); } while (0)
#define PG8_LDB(dst, b, h) do { _Pragma("unroll") for (int n = 0; n < 2; ++n) _Pragma("unroll") for (int k = 0; k < 2; ++k) dst[n][k] = *(const LAS bf16x8*)(lds + PG8_SB(b, h) + boff + n * 2048 + k * 1024); } while (0)
#define PG8_MMA(ai, bj, At, Bt) do { __builtin_amdgcn_s_setprio(1); _Pragma("unroll") for (int m = 0; m < 4; ++m) _Pragma("unroll") for (int n = 0; n < 2; ++n) _Pragma("unroll") for (int k = 0; k < 2; ++k) \
        acc[ai][bj][m][n] = __builtin_amdgcn_mfma_f32_16x16x32_bf16(Bt[n][k], At[m][k], acc[ai][bj][m][n], 0, 0, 0); __builtin_amdgcn_s_setprio(0); } while (0)
#define PG8_WAIT_V(n) asm volatile("s_waitcnt vmcnt(" #n ")" ::: "memory")
#define PG8_WAIT_L(n) asm volatile("s_waitcnt lgkmcnt(" #n ")" ::: "memory")
#define PG8_BAR __builtin_amdgcn_s_barrier()
#define PG8_SCHED __builtin_amdgcn_sched_barrier(0)
    Unit cur, nxt; int ui = 0;
    if (!S.next(0, cur)) return;
    f32x4 acc[2][2][4][2];
#pragma unroll
    for (int a = 0; a < 2; ++a)
#pragma unroll
        for (int b = 0; b < 2; ++b)
#pragma unroll
            for (int m = 0; m < 4; ++m)
#pragma unroll
                for (int n = 0; n < 2; ++n) acc[a][b][m][n] = (f32x4){0.f, 0.f, 0.f, 0.f};
    bf16x8 At[4][2], B0[2][2], B1[2][2];
    const char* cA = (const char*)g.A + (size_t)cur.pm * tstepA + (size_t)cur.pn * pnoffA; const char* cB = (const char*)g.Bt + (size_t)cur.pn * tstepB;
    PG8_STAGE(PG8_SB(0, 0), cB, voffB); PG8_STAGE(PG8_SB(0, 1), cB + hstepB, voffB); PG8_STAGE(PG8_SA(0, 0), cA, voffA); PG8_STAGE(PG8_SA(0, 1), cA + hstepA, voffA);
    if (wr == 1) PG8_BAR;
    PG8_WAIT_V(2); PG8_BAR;
    PG8_STAGE(PG8_SB(1, 0), cB + kstep, voffB); PG8_STAGE(PG8_SA(1, 0), cA + kstep, voffA); PG8_STAGE(PG8_SB(1, 1), cB + hstepB + kstep, voffB);
    PG8_WAIT_V(6); PG8_BAR;
    for (;;) {
        const bool has_next = S.next(ui + 1, nxt);
        const char* nA = has_next ? (const char*)g.A + (size_t)nxt.pm * tstepA + (size_t)nxt.pn * pnoffA : cA; const char* nB = has_next ? (const char*)g.Bt + (size_t)nxt.pn * tstepB : cB;
        for (int t = 0; t < nt; t += 2) {
            const bool last = (t == nt - 2);
            const char* a1 = cA + (size_t)(t + 1) * kstep;
            const char* a2 = last ? nA : cA + (size_t)(t + 2) * kstep; const char* b2 = last ? nB : cB + (size_t)(t + 2) * kstep;
            const char* a3 = a2 + kstep; const char* b3 = b2 + kstep;
            PG8_LDB(B0, 0, 0); PG8_LDB(B1, 0, 1); PG8_SCHED; PG8_LDA(At, 0, 0); PG8_STAGE(PG8_SA(1, 1), a1 + hstepA, voffA);
            PG8_WAIT_V(8); PG8_WAIT_L(0); PG8_BAR; PG8_MMA(0, 0, At, B0); PG8_MMA(0, 1, At, B1); PG8_BAR; PG8_SCHED;
            PG8_LDA(At, 0, 1); PG8_STAGE(PG8_SB(0, 0), b2, voffB); PG8_STAGE(PG8_SB(0, 1), b2 + hstepB, voffB); PG8_STAGE(PG8_SA(0, 0), a2, voffA);
            PG8_WAIT_V(8); PG8_WAIT_L(0); PG8_BAR; PG8_MMA(1, 0, At, B0); PG8_MMA(1, 1, At, B1); PG8_BAR; PG8_SCHED;
            PG8_LDB(B0, 1, 0); PG8_LDB(B1, 1, 1); PG8_SCHED; PG8_LDA(At, 1, 0); PG8_STAGE(PG8_SA(0, 1), a2 + hstepA, voffA);
            PG8_WAIT_V(8); PG8_WAIT_L(0); PG8_BAR; PG8_MMA(0, 0, At, B0); PG8_MMA(0, 1, At, B1); PG8_BAR; PG8_SCHED;
            PG8_LDA(At, 1, 1); PG8_STAGE(PG8_SB(1, 0), b3, voffB); PG8_STAGE(PG8_SB(1, 1), b3 + hstepB, voffB); PG8_STAGE(PG8_SA(1, 0), a3, voffA);
            PG8_WAIT_V(8); PG8_WAIT_L(0); PG8_BAR; PG8_MMA(1, 0, At, B0); PG8_MMA(1, 1, At, B1); PG8_BAR; PG8_SCHED;
        }
        if (wr == 0) PG8_BAR;
        E(acc, cur, wr, wc, fr, fq);
        if (!has_next) break;
#pragma unroll
        for (int a = 0; a < 2; ++a)
#pragma unroll
            for (int b = 0; b < 2; ++b)
#pragma unroll
                for (int m = 0; m < 4; ++m)
#pragma unroll
                    for (int n = 0; n < 2; ++n) acc[a][b][m][n] = (f32x4){0.f, 0.f, 0.f, 0.f};
        cur = nxt; cA = nA; cB = nB; ++ui;
        if (wr == 1) PG8_BAR;
    }
    PG8_WAIT_V(0);
    PG8_BAR;
#undef PG8_SA
#undef PG8_SB
#undef PG8_STAGE
#undef PG8_LDA
#undef PG8_LDB
#undef PG8_MMA
#undef PG8_WAIT_V
#undef PG8_WAIT_L
#undef PG8_BAR
#undef PG8_SCHED
}
}

namespace att {
constexpr int R = 288;
constexpr int K_OFF = 0, K_BYTES = 8 * R * 16, V_OFF = K_BYTES, V_BYTES = 2 * R * 64, TB_OFF = V_OFF + V_BYTES, TOTAL = TB_OFF + 4 * 256 * 4;
static_assert(TOTAL <= RING_BYTES, "attention LDS");
__device__ __forceinline__ s16x4 vtr(const LAS unsigned char* p) { return __builtin_amdgcn_ds_read_tr16_b64_v4i16((LAS s16x4*)p); }

template <int NT, bool META>
__device__ __forceinline__ void group(const LAS unsigned char* lds, const bf16_t* qkv, bf16_t* o, float sink2, int b, int kvh, int nblk, int g, int qs, int lane) {
    const int q = lane & 31, hi = lane >> 5, hq = 4 * kvh + g;
    int row; if (META) row = MR + b * NMETA + (q < NMETA ? q : NMETA - 1); else row = b * S + nblk * 128 + 32 * qs + q;
    bf16x8 qf[4];
#pragma unroll
    for (int ds = 0; ds < 4; ++ds) qf[ds] = *(const bf16x8*)(qkv + (size_t)row * NQKV + hq * 64 + 16 * ds + 8 * hi);
    f32x16 sc[NT];
#pragma unroll
    for (int ti = 0; ti < NT; ++ti) {
        const int rb = ti == 0 ? 0 : 32 * (qs + ti);
        f32x16 a = {};
#pragma unroll
        for (int ds = 0; ds < 4; ++ds) { const bf16x8 kf = *(const LAS bf16x8*)(lds + K_OFF + (2 * ds + hi) * (R * 16) + (rb + q) * 16); a = __builtin_amdgcn_mfma_f32_32x32x16_bf16(kf, qf[ds], a, 0, 0, 0); }
        sc[ti] = a;
    }
    const LAS float* tb = (const LAS float*)(lds + TB_OFF) + g * 256;
    float mx = sink2;
    int base[16];
#pragma unroll
    for (int r = 0; r < 16; ++r) base[r] = (r & 3) + 8 * (r >> 2) + 4 * hi - q;
#pragma unroll
    for (int ti = 0; ti < NT; ++ti) {
        if (ti == 0) {
#pragma unroll
            for (int r = 0; r < 16; ++r) {
                float v = -1e30f;
                if (r < 8) {
                    const int kk = (r & 3) + 8 * (r >> 2) + 4 * hi;
                    if (META) { v = kk <= q ? sc[0][r] + tb[(q - kk) & 255] : -1e30f; }
                    else { int dist = NMETA + nblk * 128 + 32 * qs + q - kk; dist = dist > 255 ? 255 : dist; v = sc[0][r] + tb[dist]; }
                }
                sc[0][r] = v; mx = fmaxf(mx, v);
            }
        } else {
            const bool tile_ok = nblk > 0 || qs + ti - 1 >= 4;
#pragma unroll
            for (int r = 0; r < 16; ++r) {
                const float bias = tb[128 - 32 * (ti - 1) - base[r]];
                bool valid = tile_ok;
                if (ti == 1) valid = valid && base[r] >= 1;
                if (ti == 5) valid = valid && base[r] <= 0;
                const float v = valid ? sc[ti][r] + bias : -1e30f; sc[ti][r] = v; mx = fmaxf(mx, v);
            }
        }
    }
    mx = fmaxf(mx, __shfl_xor(mx, 32));
    float ls = 0.f;
#pragma unroll
    for (int ti = 0; ti < NT; ++ti)
#pragma unroll
        for (int r = 0; r < 16; ++r) { const float p = __builtin_amdgcn_exp2f(sc[ti][r] - mx); sc[ti][r] = p; ls += p; }
    ls += __shfl_xor(ls, 32); ls += __builtin_amdgcn_exp2f(sink2 - mx);
    f32x16 oT[2]; oT[0] = f32x16{}; oT[1] = f32x16{};
#pragma unroll
    for (int ti = 0; ti < NT; ++ti) {
        const int rb = ti == 0 ? 0 : 32 * (qs + ti);
#pragma unroll
        for (int s = 0; s < 2; ++s) {
            u32x4 pw; pw.x = cvtpk(sc[ti][8 * s + 0], sc[ti][8 * s + 1]); pw.y = cvtpk(sc[ti][8 * s + 2], sc[ti][8 * s + 3]); pw.z = cvtpk(sc[ti][8 * s + 4], sc[ti][8 * s + 5]); pw.w = cvtpk(sc[ti][8 * s + 6], sc[ti][8 * s + 7]);
            const bf16x8 pf = __builtin_bit_cast(bf16x8, pw);
#pragma unroll
            for (int dt = 0; dt < 2; ++dt) {
                const LAS unsigned char* vp = lds + V_OFF + dt * (R * 64) + (rb + 16 * s + 4 * hi + ((lane & 15) >> 2)) * 64 + ((lane >> 4) & 1) * 32 + (lane & 3) * 8;
                const s16x4 lo = vtr(vp), h4 = vtr(vp + 512);
                const bf16x8 vf = (bf16x8){lo[0], lo[1], lo[2], lo[3], h4[0], h4[1], h4[2], h4[3]};
                oT[dt] = __builtin_amdgcn_mfma_f32_32x32x16_bf16(vf, pf, oT[dt], 0, 0, 0);
            }
        }
    }
    const float inv = 1.0f / ls;
    if (!META || q < NMETA) {
#pragma unroll
        for (int dt = 0; dt < 2; ++dt)
#pragma unroll
            for (int rg = 0; rg < 4; ++rg) {
                u32x2 w; w.x = cvtpk(oT[dt][4 * rg + 0] * inv, oT[dt][4 * rg + 1] * inv); w.y = cvtpk(oT[dt][4 * rg + 2] * inv, oT[dt][4 * rg + 3] * inv);
                *(u32x2*)(o + (size_t)row * D + hq * 64 + 32 * dt + 8 * rg + 4 * hi) = w;
            }
    }
}

__device__ __forceinline__ void unit(LAS unsigned char* lds, const bf16_t* qkv, bf16_t* o, const float* TBg, const float* sinks, int b, int kvh, int nblk, int tid) {
    asm volatile("" : "+v"(tid));
    const int lane = tid & 63, wid = __builtin_amdgcn_readfirstlane(tid >> 6);
#pragma unroll
    for (int i = 0; i < 9; ++i) {
        const int task = tid + NTHR * i, isv = task >= 8 * R ? 1 : 0, rem = task - isv * 8 * R, row = rem >> 3, ch = rem & 7;
        int grow = -1;
        if (row < 32) { if (row < NMETA) grow = MR + b * NMETA + row; }
        else { const int jk = row - 32; if (nblk < 64 && (nblk > 0 || jk >= 128)) grow = b * S + (nblk - 1) * 128 + jk; }
        u32x4 v = (u32x4){0u, 0u, 0u, 0u};
        if (grow >= 0) v = *(const u32x4*)(qkv + (size_t)grow * NQKV + 1024 + isv * 256 + kvh * 64 + ch * 8);
        const int dst = isv ? V_OFF + (ch >> 2) * (R * 64) + row * 64 + (ch & 3) * 16 : K_OFF + ch * (R * 16) + row * 16;
        *(LAS u32x4*)(lds + dst) = v;
    }
    { LAS float* tb = (LAS float*)(lds + TB_OFF); tb[tid] = TBg[(size_t)(4 * kvh) * 256 + tid]; tb[tid + 512] = TBg[(size_t)(4 * kvh) * 256 + tid + 512]; }
    __syncthreads();
    const int g = wid >> 1;
    const float sink2 = sinks[4 * kvh + g] * LOG2E;
    if (nblk < 64) {
#pragma unroll 1
        for (int i = 0; i < 2; ++i) group<6, false>(lds, qkv, o, sink2, b, kvh, nblk, g, 2 * (wid & 1) + i, lane);
    } else if ((wid & 1) == 0) {
        group<1, true>(lds, qkv, o, sink2, b, kvh, nblk, g, 0, lane);
    }
    __syncthreads();
}
}

#define XB_TMO      128
#define XB_XCNT(j)  (256  + 64 * (j))
#define XB_XSUB(j)  (1280 + 64 * (j))
#define XB_XGEN(j)  (2304 + 64 * (j))
#define XB_TOP      3328
#define XB_TOPGEN   3392
#define XCD_BAR_WORDS 3456
#define XB_SPIN_CAP (1u << 18)
__device__ __forceinline__ unsigned xb_ld(unsigned* p)              { return __hip_atomic_load(p, __ATOMIC_RELAXED, __HIP_MEMORY_SCOPE_AGENT); }
__device__ __forceinline__ unsigned xb_add(unsigned* p, unsigned v) { return __hip_atomic_fetch_add(p, v, __ATOMIC_RELAXED, __HIP_MEMORY_SCOPE_AGENT); }
__device__ __forceinline__ unsigned xb_xcc_id() { return (unsigned)__builtin_amdgcn_s_getreg((3 << 11) | 20) & 0xFu; }
#define XB_SPIN(cond, bar) do { unsigned _sp = 0; while (cond) { __builtin_amdgcn_s_sleep(1); \
    if ((++_sp & 255u) == 0u) { if (xb_ld(&(bar)[XB_TMO])) break; if (_sp > XB_SPIN_CAP) { atomicAdd(&(bar)[XB_TMO], 1u); break; } } } } while (0)
struct XcdBarrier { unsigned* bar; unsigned x; volatile LAS unsigned* st; };
__device__ __forceinline__ XcdBarrier xcd_barrier_post(unsigned* bar, volatile LAS unsigned* st) {
    XcdBarrier b; b.bar = bar; b.x = xb_xcc_id(); b.st = st;
    if (threadIdx.x == 0) (void)xb_add(&bar[XB_XCNT(b.x)], 1u);
    return b;
}
__device__ __forceinline__ void xcd_barrier_complete(unsigned* bar, unsigned x, unsigned& nloc, unsigned& nx) {
    const unsigned G = gridDim.x * gridDim.y * gridDim.z;
    unsigned sum, cnt, mine, sp = 0u;
    for (;;) {
        sum = 0u; cnt = 0u; mine = 0u;
#pragma unroll
        for (unsigned j = 0; j < 16; ++j) { const unsigned c = xb_ld(&bar[XB_XCNT(j)]); sum += c; cnt += (c > 0u) ? 1u : 0u; mine = (j == x) ? c : mine; }
        if (sum == G) break;
        __builtin_amdgcn_s_sleep(1);
        if ((++sp & 255u) == 0u) { if (xb_ld(&bar[XB_TMO])) break; if (sp > XB_SPIN_CAP) { atomicAdd(&bar[XB_TMO], 1u); break; } }
    }
    nloc = mine > 0u ? mine : 1u; nx = cnt > 0u ? cnt : 1u;
}
__device__ __forceinline__ void xcd_barrier(const XcdBarrier& b) {
    asm volatile("s_waitcnt vmcnt(0)" ::: "memory");
    __syncthreads();
    if (threadIdx.x == 0) {
        unsigned* bar = b.bar;
        __builtin_amdgcn_s_waitcnt(0);
        unsigned nloc = b.st[0], nx = b.st[1];
        if (nloc == 0u) { xcd_barrier_complete(bar, b.x, nloc, nx); b.st[0] = nloc; b.st[1] = nx; }
        const unsigned old = xb_add(&bar[XB_XSUB(b.x)], 1u);
        const unsigned gen = old / nloc;
        if (old + 1u == (gen + 1u) * nloc) {
            __builtin_amdgcn_fence(__ATOMIC_RELEASE, "agent");
            asm volatile("s_waitcnt vmcnt(0)" ::: "memory");
            const unsigned og = xb_add(&bar[XB_TOP], 1u);
            const unsigned tg = og / nx;
            if (og + 1u == (tg + 1u) * nx) xb_add(&bar[XB_TOPGEN], 1u);
            else XB_SPIN(xb_ld(&bar[XB_TOPGEN]) == tg, bar);
            __builtin_amdgcn_fence(__ATOMIC_ACQUIRE, "agent");
            xb_add(&bar[XB_XGEN(b.x)], 1u);
            asm volatile("s_waitcnt vmcnt(0)" ::: "memory");
        } else {
            XB_SPIN(xb_ld(&bar[XB_XGEN(b.x)]) == gen, bar);
            __builtin_amdgcn_fence(__ATOMIC_ACQUIRE, "agent");
            asm volatile("s_waitcnt vmcnt(0)" ::: "memory");
        }
    }
    __syncthreads();
}

__device__ __forceinline__ void transpose_item(const float* W, int N, bf16_t* WT, int ldt, int k0, int n0, int drow0, const float* gain, LAS float* scr, int lane) {
#pragma unroll 8
    for (int i = 0; i < 32; ++i) { const int kk = 2 * i + (lane >> 5); float w = W[(size_t)(k0 + kk) * N + n0 + (lane & 31)]; if (gain) w *= gain[k0 + kk]; scr[kk * 33 + (lane & 31)] = w; }
    LDS_WAIT(); asm volatile("" ::: "memory");
    const int c = lane & 7;
#pragma unroll
    for (int j = 0; j < 4; ++j) { const int n = (lane >> 3) + 8 * j; const LAS float* s = scr + (8 * c) * 33 + n;
        u32x4 o; o.x = cvtpk(s[0 * 33], s[1 * 33]); o.y = cvtpk(s[2 * 33], s[3 * 33]); o.z = cvtpk(s[4 * 33], s[5 * 33]); o.w = cvtpk(s[6 * 33], s[7 * 33]);
        *(u32x4*)(WT + (size_t)(drow0 + n) * ldt + k0 + 8 * c) = o; }
    LDS_WAIT(); asm volatile("" ::: "memory");
}

struct Args { const float* in[19]; float* out; unsigned char* ws; int ph_lo, ph_hi; };
constexpr int N_PHASES = 21;

__global__ void __launch_bounds__(NTHR, 2) mega_fwd(Args args) {
    extern __shared__ __attribute__((aligned(16))) unsigned char lds_raw[];
    LAS unsigned char* lds = (LAS unsigned char*)lds_raw;
    const int G = gridDim.x, bx = blockIdx.x;
    const int vcu = (G % 8 == 0) ? (bx % 8) * (G / 8) + bx / 8 : bx;
    for (int u = threadIdx.x; u < (LDS_BYTES - LDSCTL_OFF) / 4; u += NTHR) ((LAS unsigned*)(lds + LDSCTL_OFF))[u] = 0u;
    __syncthreads();
    XcdBarrier bar; bar.bar = (unsigned*)(args.ws + WS_CTL) + CW_BAR; bar.x = 0; bar.st = nullptr;
    if (MK_N_LAUNCHES == 1) bar = xcd_barrier_post((unsigned*)(args.ws + WS_CTL) + CW_BAR, (volatile LAS unsigned*)(lds + MISC_OFF) + 8);

    for (int ph = args.ph_lo; ph < args.ph_hi; ++ph) {
        int tid = threadIdx.x; asm volatile("" : "+v"(tid));
        unsigned long long zoff = 0; asm volatile("" : "+s"(zoff));
        unsigned char* ws = args.ws + zoff;
        const int lane = tid & 63, wave = __builtin_amdgcn_readfirstlane(tid >> 6);
        const float* x = args.in[0]; const float* meta_tok = args.in[1]; const float* rel_table = args.in[2];
        const float* norm_mix = args.in[3]; const float* norm_ffn = args.in[4]; const float* norm_final = args.in[5];
        const float* bqkv = args.in[7]; const float* bo = args.in[9]; const float* sinks = args.in[10];
        const float* conv_w = args.in[12]; const float* pool_scale = args.in[15];
        float* dout = args.out;
        float* hmeta = (float*)(ws + WS_HMETA); float* ssq = (float*)(ws + WS_SSQ); float* TB = (float*)(ws + WS_TB);
        bf16_t* HB = (bf16_t*)(ws + WS_HB); unsigned char* wts = ws + WS_W; unsigned char* big = ws + WS_BIG;
        const int gw = vcu * NWAVES + wave, NGW = G * NWAVES;
        const int gtid = vcu * NTHR + tid, NGT = G * NTHR;
        if (ph == 0) {
            LAS float* scr = (LAS float*)(lds + wave * 16384);
            constexpr int I_ATT = 768 + 512, I_CONV = 1536 + 512, I_POOL = 128, I_FFN = 3 * 1408, NITEMS = 2 * I_ATT + I_CONV + I_POOL + 4 * I_FFN;
            for (int it = gw; it < NITEMS; it += NGW) {
                int r = it;
                if (r < 2 * I_ATT) {
                    const int j = r / I_ATT; r -= j * I_ATT; unsigned char* wl = wts + j * W_ATT_STRIDE;
                    if (r < 768) { const int kb = r / 48, nb = r % 48; transpose_item(args.in[6] + (size_t)j * D * NQKV, NQKV, (bf16_t*)(wl + W_QKV), D, 64 * kb, 32 * nb, 32 * nb, norm_mix + (size_t)(3 * j) * D, scr, lane); }
                    else { r -= 768; const int kb = r / 32, nb = r % 32; transpose_item(args.in[8] + (size_t)j * D * D, D, (bf16_t*)(wl + W_O), D, 64 * kb, 32 * nb, 32 * nb, nullptr, scr, lane); }
                    continue;
                }
                r -= 2 * I_ATT;
                if (r < I_CONV) {
                    if (r < 1536) { const int kb = r / 96, nb = r % 96, n0 = 32 * nb; int drow;
                        if (n0 < 1024) drow = n0; else { const int c = (n0 - 1024) & 1023, isu = n0 >= 2048 ? 1 : 0; drow = 1024 + 256 * (c >> 7) + 128 * isu + (c & 127); }
                        transpose_item(args.in[11], 3 * D, (bf16_t*)(wts + W_CIN), D, 64 * kb, n0, drow, norm_mix + (size_t)1 * D, scr, lane); }
                    else { r -= 1536; const int kb = r / 32, nb = r % 32; transpose_item(args.in[13], D, (bf16_t*)(wts + W_COUT), D, 64 * kb, 32 * nb, 32 * nb, nullptr, scr, lane); }
                    continue;
                }
                r -= I_CONV;
                if (r < I_POOL) { const int gi = r / 32; r -= gi * 32; const int kb = r / 8, nb = r % 8;
                    transpose_item(args.in[14] + (size_t)gi * 256 * 256, 256, (bf16_t*)(wts + W_POOL), 256, 64 * kb, 32 * nb, gi * 256 + 32 * nb, nullptr, scr, lane); continue; }
                r -= I_POOL;
                { const int i = r / I_FFN; r -= i * I_FFN; unsigned char* wl = wts + W_FFN + i * W_FFN_STRIDE;
                  if (r < 2816) { const int isu = r >= 1408 ? 1 : 0; r -= isu * 1408; const int kb = r / 88, nb = r % 88, n0 = 32 * nb;
                      transpose_item(args.in[16 + isu] + (size_t)i * D * FF, FF, (bf16_t*)(wl + W_GU), D, 64 * kb, n0, 256 * (n0 >> 7) + 128 * isu + (n0 & 127), norm_ffn + (size_t)i * D, scr, lane); }
                  else { r -= 2816; const int kb = r / 32, nb = r % 32; transpose_item(args.in[18] + (size_t)i * FF * D, D, (bf16_t*)(wl + W_DN), FF, 64 * kb, 32 * nb, 32 * nb, nullptr, scr, lane); } }
            }
            for (int i = gtid; i < NH * 256; i += NGT) { const int h = i >> 8, dist = i & 255; TB[i] = rel_table[bucket_of(dist) * NH + h] * LOG2E; }
            for (int r = gw; r < MT; r += NGW) {
                const float* src = r < MR ? x + (size_t)r * D : meta_tok + (size_t)((r - MR) & (NMETA - 1)) * D;
                const f32x4* xr = (const f32x4*)src + lane; f32x4 v[4]; float s = 0.f;
#pragma unroll
                for (int j = 0; j < 4; ++j) { v[j] = xr[64 * j]; s += (v[j][0] * v[j][0] + v[j][1] * v[j][1]) + (v[j][2] * v[j][2] + v[j][3] * v[j][3]); }
                s = wave_sum(s);
                u32x2* o8 = (u32x2*)(HB + (size_t)r * D) + lane;
#pragma unroll
                for (int j = 0; j < 4; ++j) { u32x2 w; w.x = cvtpk(v[j][0], v[j][1]); w.y = cvtpk(v[j][2], v[j][3]); o8[64 * j] = w; }
                if (r >= MR) { f32x4* hm = (f32x4*)(hmeta + (size_t)(r - MR) * D) + lane;
#pragma unroll
                    for (int j = 0; j < 4; ++j) hm[64 * j] = v[j]; }
                if (lane < 16) ssq[(size_t)r * 16 + lane] = lane == 0 ? s : 0.f;
            }
        } else if (ph == 20) {
            for (int r = gw; r < MR; r += NGW) {
                float p = lane < 16 ? ssq[(size_t)r * 16 + lane] : 0.f; p = wave_sum(p);
                const float rs = 1.0f / sqrtf(p * (1.0f / D) + EPS);
                f32x4* xr = (f32x4*)(dout + (size_t)r * D) + lane; const f32x4* gr = (const f32x4*)norm_final + lane;
#pragma unroll
                for (int j = 0; j < 4; ++j) { f32x4 v = xr[64 * j]; const f32x4 gg = gr[64 * j]; xr[64 * j] = v * rs * gg; }
            }
        } else {
            const int li = ph <= 5 ? 0 : (ph <= 10 ? 1 : (ph <= 14 ? 2 : 3));
            const int first = li == 0 ? 1 : (li == 1 ? 6 : (li == 2 ? 11 : 15));
            const int last = li == 0 ? 5 : (li == 1 ? 10 : (li == 2 ? 14 : 19));
            unsigned char* wffn = wts + W_FFN + li * W_FFN_STRIDE;
            if (ph == last - 1) {
                pg8::Gemm g{HB, (const bf16_t*)(wffn + W_GU), D, D, D, 0}; pg8::StaticOrder So; So.init(65, 22, G, bx);
                pg8::EpiSwiGLU E{(bf16_t*)big, ssq};
                pg8::gemm_phase<pg8::EpiSwiGLU>(lds, g, So, E, tid);
            } else if (ph == last) {
                pg8::Gemm g{(const bf16_t*)big, (const bf16_t*)(wffn + W_DN), FF, FF, FF, 0}; pg8::StaticOrder So; So.init(65, 4, G, bx);
                pg8::EpiResid E{dout, hmeta, dout, hmeta, HB, ssq, nullptr, nullptr};
                pg8::gemm_phase<pg8::EpiResid>(lds, g, So, E, tid);
            } else if (li == 0 || li == 3) {
                const int j = li == 0 ? 0 : 1; unsigned char* wl = wts + j * W_ATT_STRIDE;
                bf16_t* qkv = (bf16_t*)(big + BIG_QKV); bf16_t* ob = (bf16_t*)(big + BIG_O);
                if (ph == first) {
                    pg8::Gemm g{HB, (const bf16_t*)(wl + W_QKV), D, D, D, 0}; pg8::StaticOrder So; So.init(65, 6, G, bx);
                    pg8::EpiQKV E{qkv, bqkv + (size_t)j * NQKV, ssq};
                    pg8::gemm_phase<pg8::EpiQKV>(lds, g, So, E, tid);
                } else if (ph == first + 1) {
                    for (int ui = vcu; ui < NB * NKV * 65; ui += G) {
                        const int nblk = ui % 65, bk = ui / 65;
                        att::unit(lds, qkv, ob, TB, sinks + (size_t)j * NH, bk >> 2, bk & 3, nblk, tid);
                    }
                } else {
                    pg8::Gemm g{ob, (const bf16_t*)(wl + W_O), D, D, D, 0}; pg8::StaticOrder So; So.init(65, 4, G, bx);
                    pg8::EpiResid E{li == 0 ? x : dout, hmeta, dout, hmeta, HB, ssq, bo + (size_t)j * D, nullptr};
                    pg8::gemm_phase<pg8::EpiResid>(lds, g, So, E, tid);
                }
            } else if (li == 1) {
                bf16_t* GBb = (bf16_t*)(big + BIG_GB); bf16_t* Zb = (bf16_t*)(big + BIG_Z); bf16_t* Gb = (bf16_t*)(big + BIG_G);
                if (ph == first) {
                    pg8::Gemm g{HB, (const bf16_t*)(wts + W_CIN), D, D, D, 0}; pg8::StaticOrder So; So.init(65, 12, G, bx);
                    pg8::EpiConvIn E{GBb, Zb, ssq};
                    pg8::gemm_phase<pg8::EpiConvIn>(lds, g, So, E, tid);
                } else if (ph == first + 1) {
                    for (int it = gtid; it < MT * 128; it += NGT) {
                        const int r = it >> 7, c8 = (it & 127) * 8;
                        int r1, r2;
                        if (r < MR) { const int s = r & (S - 1), b = r >> 13; r1 = s >= 1 ? r - 1 : MR + b * NMETA + 15; r2 = s >= 2 ? r - 2 : MR + b * NMETA + 14 + s; }
                        else { const int m = (r - MR) & 15; r1 = m >= 1 ? r - 1 : -1; r2 = m >= 2 ? r - 2 : -1; }
                        const u32x4 z0 = *(const u32x4*)(Zb + (size_t)r * D + c8);
                        u32x4 z1 = (u32x4){0u, 0u, 0u, 0u}, z2 = (u32x4){0u, 0u, 0u, 0u};
                        if (r1 >= 0) z1 = *(const u32x4*)(Zb + (size_t)r1 * D + c8);
                        if (r2 >= 0) z2 = *(const u32x4*)(Zb + (size_t)r2 * D + c8);
                        const u32x4 gb = *(const u32x4*)(GBb + (size_t)r * D + c8);
                        const float* w0 = conv_w + c8; const float* w1 = conv_w + D + c8; const float* w2 = conv_w + 2 * D + c8;
                        u32x4 ov;
#pragma unroll
                        for (int e = 0; e < 4; ++e) {
                            const unsigned a0 = z0[e], a1 = z1[e], a2 = z2[e], ag = gb[e];
                            const float lo = bf2f((unsigned short)(ag & 0xffffu)) * (w2[2 * e] * bf2f((unsigned short)(a0 & 0xffffu)) + w1[2 * e] * bf2f((unsigned short)(a1 & 0xffffu)) + w0[2 * e] * bf2f((unsigned short)(a2 & 0xffffu)));
                            const float hi = bf2f((unsigned short)(ag >> 16)) * (w2[2 * e + 1] * bf2f((unsigned short)(a0 >> 16)) + w1[2 * e + 1] * bf2f((unsigned short)(a1 >> 16)) + w0[2 * e + 1] * bf2f((unsigned short)(a2 >> 16)));
                            ov[e] = cvtpk(lo, hi);
                        }
                        *(u32x4*)(Gb + (size_t)r * D + c8) = ov;
                    }
                } else {
                    pg8::Gemm g{Gb, (const bf16_t*)(wts + W_COUT), D, D, D, 0}; pg8::StaticOrder So; So.init(65, 4, G, bx);
                    pg8::EpiResid E{dout, hmeta, dout, hmeta, HB, ssq, nullptr, nullptr};
                    pg8::gemm_phase<pg8::EpiResid>(lds, g, So, E, tid);
                }
            } else {
                bf16_t* MIX = (bf16_t*)big;
                if (ph == first) {
                    LAS float* rsl = (LAS float*)lds;
                    const float* gmix = norm_mix + (size_t)2 * D;
                    for (int ui = vcu; ui < NB * 129; ui += G) {
                        const int b = ui / 129, t0 = (ui % 129) * 64;
                        __syncthreads();
                        if (tid < 79) { const int t = t0 - 15 + tid; float rs = 0.f;
                            if (t >= 0 && t < LSEQ) { const int row = rowof(b, t); const f32x4* p = (const f32x4*)(ssq + (size_t)row * 16); const f32x4 a = p[0], bb = p[1], c = p[2], d = p[3];
                                const float s = ((a[0] + a[1]) + (a[2] + a[3])) + ((bb[0] + bb[1]) + (bb[2] + bb[3])) + ((c[0] + c[1]) + (c[2] + c[3])) + ((d[0] + d[1]) + (d[2] + d[3]));
                                rs = 1.0f / sqrtf(s * (1.0f / D) + EPS); }
                            rsl[tid] = rs; }
                        __syncthreads();
                        const int c = 2 * tid, win = 2 << (c >> 8);
                        const f32x2 gg = *(const f32x2*)(gmix + c);
#define POOL_A(t) ({ const int _t = (t); f32x2 _a = (f32x2){0.f, 0.f}; if (_t >= 0) { const int _row = rowof(b, _t); const float* _hp = _row < MR ? dout + (size_t)_row * D : hmeta + (size_t)(_row - MR) * D; \
                            const f32x2 _h = *(const f32x2*)(_hp + c); const float _rs = rsl[_t - (t0 - 15)]; _a = _h * _rs * gg; } _a; })
                        f32x2 Ssum = (f32x2){0.f, 0.f};
                        for (int jj = 1; jj < win; ++jj) Ssum += POOL_A(t0 - jj);
                        const int tend = t0 + 64 < LSEQ ? t0 + 64 : LSEQ;
                        for (int t = t0; t < tend; ++t) {
                            const f32x2 at = POOL_A(t); Ssum += at;
                            const int cnt = win < t + 1 ? win : t + 1; const float ic = 1.0f / (float)cnt;
                            const f32x2 mx = Ssum * ic - at;
                            *(unsigned*)(MIX + (size_t)rowof(b, t) * D + c) = cvtpk(mx[0], mx[1]);
                            Ssum -= POOL_A(t - win + 1);
                        }
#undef POOL_A
                    }
                    __syncthreads();
                } else {
                    pg8::Gemm g{MIX, (const bf16_t*)(wts + W_POOL), D, 256, 256, 256}; pg8::StaticOrder So; So.init(65, 4, G, bx);
                    pg8::EpiResid E{dout, hmeta, dout, hmeta, HB, ssq, nullptr, pool_scale};
                    pg8::gemm_phase<pg8::EpiResid>(lds, g, So, E, tid);
                }
            }
        }
        if (MK_N_LAUNCHES == 1 && ph + 1 < args.ph_hi) xcd_barrier(bar);
    }
}

extern "C" void kernel_launch(void* const* d_in, const int* in_sizes, int n_in, void* d_out, int out_size, void* d_ws, size_t ws_size, hipStream_t stream) {
    static int grid = 0;
    if (grid == 0) {
        if (n_in != 19 || out_size != MR * D || ws_size < WS_END) { fprintf(stderr, "kernel_launch: unexpected shapes (n_in %d out %d ws %zu)\n", n_in, out_size, ws_size); grid = -1; return; }
        int dev = 0, cus = 0, per_cu = 0;
        if (hipGetDevice(&dev) != hipSuccess || hipDeviceGetAttribute(&cus, hipDeviceAttributeMultiprocessorCount, dev) != hipSuccess) { grid = -1; return; }
        if (hipFuncSetAttribute((const void*)mega_fwd, hipFuncAttributeMaxDynamicSharedMemorySize, LDS_BYTES) != hipSuccess) { fprintf(stderr, "kernel_launch: hipFuncSetAttribute failed\n"); grid = -1; return; }
        if (hipOccupancyMaxActiveBlocksPerMultiprocessor(&per_cu, (const void*)mega_fwd, NTHR, LDS_BYTES) != hipSuccess || per_cu < 1) { fprintf(stderr, "kernel_launch: occupancy query says %d blocks/CU\n", per_cu); }
        (void)hipGetLastError();
        grid = cus;
    }
    if (grid < 0) return;
    if (hipMemsetAsync((char*)d_ws + WS_CTL, 0, CTL_ZERO_BYTES, stream) != hipSuccess) { fprintf(stderr, "kernel_launch: memset failed\n"); return; }
    Args a{};
    for (int i = 0; i < 19; ++i) a.in[i] = (const float*)d_in[i];
    a.out = (float*)d_out; a.ws = (unsigned char*)d_ws;
    if (MK_N_LAUNCHES == 1) {
        a.ph_lo = 0; a.ph_hi = N_PHASES;
        hipLaunchKernelGGL(mega_fwd, dim3(grid), dim3(NTHR), LDS_BYTES, stream, a);
    } else {
        for (int ph = 0; ph < N_PHASES; ++ph) { a.ph_lo = ph; a.ph_hi = ph + 1; hipLaunchKernelGGL(mega_fwd, dim3(grid), dim3(NTHR), LDS_BYTES, stream, a); }
    }
}
```

```cpp
#include <hip/hip_runtime.h>
#include <cstdio>
#include <cstdint>

#ifndef MK_N_LAUNCHES
#define MK_N_LAUNCHES 1
#endif

#define LAS __attribute__((address_space(3)))
#define GAS __attribute__((address_space(1)))
typedef unsigned short bf16_t;
typedef short bf16x8 __attribute__((ext_vector_type(8)));
typedef short s16x4 __attribute__((ext_vector_type(4)));
typedef float f32x2 __attribute__((ext_vector_type(2)));
typedef float f32x4 __attribute__((ext_vector_type(4)));
typedef float f32x16 __attribute__((ext_vector_type(16)));
typedef unsigned u32x2 __attribute__((ext_vector_type(2)));
typedef unsigned u32x4 __attribute__((ext_vector_type(4)));
typedef __bf16 bf16x2_t __attribute__((ext_vector_type(2)));

constexpr int D = 1024, NB = 2, S = 8192, NMETA = 16, LSEQ = S + NMETA;
constexpr int MR = NB * S;
constexpr int MT = MR + NB * NMETA;
constexpr int MP = 65 * 256;
constexpr int NH = 16, NKV = 4, HD = 64, NQKV = 1536, FF = 2816;
constexpr float EPS = 1e-6f;
constexpr float LOG2E = 1.4426950408889634f;
constexpr float QSCALE = 0.125f * LOG2E;
constexpr int NWAVES = 8, NTHR = 512;

constexpr size_t MiB = 1u << 20;
constexpr size_t WS_CTL = 0, CTL_ZERO_BYTES = 1 * MiB;
constexpr size_t WS_HMETA = 1 * MiB;
constexpr size_t WS_SSQ = 2 * MiB;
constexpr size_t WS_TB = 4 * MiB;
constexpr size_t WS_W = 5 * MiB;
constexpr size_t W_QKV = 0, W_O = 3 * MiB, W_ATT_STRIDE = 5 * MiB;
constexpr size_t W_CIN = 10 * MiB, W_COUT = 16 * MiB, W_POOL = 18 * MiB;
constexpr size_t W_FFN = 19 * MiB, W_FFN_STRIDE = 33 * MiB / 2, W_GU = 0, W_DN = 11 * MiB;
constexpr size_t WS_HB = 90 * MiB;
constexpr size_t WS_BIG = 123 * MiB;
constexpr size_t BIG_QKV = 0, BIG_O = 49 * MiB;
constexpr size_t BIG_GB = 0, BIG_Z = 33 * MiB, BIG_G = 66 * MiB;
constexpr size_t WS_END = 256 * MiB;
static_assert(W_FFN + 4 * W_FFN_STRIDE <= 85 * MiB && WS_W + 85 * MiB <= WS_HB, "weights");
static_assert(WS_HB + (size_t)MP * D * 2 <= WS_BIG && WS_BIG + (size_t)MP * FF * 2 <= WS_END, "ws map");

constexpr int CW_BAR = 4096;

constexpr int RING_BYTES = 131072;
constexpr int LDSCTL_OFF = RING_BYTES, MISC_OFF = LDSCTL_OFF + 320;
constexpr int LDS_BYTES = 147456;

__device__ __forceinline__ unsigned cvtpk(float lo, float hi) { f32x2 v = {lo, hi}; bf16x2_t b = __builtin_convertvector(v, bf16x2_t); return __builtin_bit_cast(unsigned, b); }
__device__ __forceinline__ float bf2f(unsigned short u) { return __builtin_bit_cast(float, (unsigned)u << 16); }
__device__ __forceinline__ float wave_sum(float v) {
#pragma unroll
    for (int o = 1; o < 64; o <<= 1) v += __shfl_xor(v, o);
    return v;
}
__device__ __forceinline__ int rowof(int b, int t) { return t < NMETA ? MR + b * NMETA + t : b * S + (t - NMETA); }
__device__ __forceinline__ int bucket_of(int dist) {
    if (dist < 16) return dist < 0 ? 0 : dist;
    int v = 16 + (int)(log2f((float)dist * 0.0625f) * (16.0f / 3.0f));
    return v > 31 ? 31 : v;
}
#define LDS_WAIT() asm volatile("s_waitcnt lgkmcnt(0)" ::: "memory")
#define VM_WAIT() asm volatile("s_waitcnt vmcnt(0)" ::: "memory")

namespace pg8 {
constexpr int BM = 256, BK = 64, HALF = 128, HTB = HALF * BK * 2, STAGE_BYTES = 8 * HTB, NXCD = 8, WGM = 8;
__host__ __device__ __forceinline__ int lds_byte(int r, int c) { const int st = (r >> 4) * 2 + (c >> 5), rr = r & 15, cc = c & 31, ob = rr * 64 + cc * 2; return st * 1024 + (ob ^ (((ob >> 9) & 1) << 5)); }
__host__ __device__ __forceinline__ void stage_rc(int b, int& R, int& C) { const int st = b / 1024, sb = b % 1024, swz = sb ^ (((sb >> 9) & 1) << 5); R = (st >> 1) * 16 + swz / 64; C = (st & 1) * 32 + (swz % 64) / 2; }
__host__ __device__ __forceinline__ int perm32(int rho) { const int n = rho >> 4, i = rho & 15; return 8 * (i >> 2) + 4 * n + (i & 3); }

struct Unit { int pm, pn; };
struct Gemm { const bf16_t* A; const bf16_t* Bt; int lda, ldb, K, a_pn_off; };

struct StaticOrder {
    int nM, nN, nwg, G, c;
    __device__ void init(int nM_, int nN_, int G_, int c_) { nM = nM_; nN = nN_; nwg = nM * nN; G = G_; c = c_; }
    __device__ bool next(int i, Unit& u) const {
        const long L = (long)i * G + c; if (L >= nwg) return false;
        int wgid = (int)L; { const int q = nwg / NXCD, r = nwg % NXCD, xcd = wgid % NXCD, off = wgid / NXCD; wgid = (xcd < r ? xcd * (q + 1) : r * (q + 1) + (xcd - r) * q) + off; }
        const int nig = WGM * nN, gid = wgid / nig, fm = gid * WGM, gsz = (nM - fm) < WGM ? (nM - fm) : WGM;
        u.pm = fm + ((wgid % nig) % gsz); u.pn = (wgid % nig) / gsz; return true;
    }
};

__device__ __forceinline__ float rstd_of(const float* ssq, int row) {
    const f32x4* p = (const f32x4*)(ssq + (size_t)row * 16);
    const f32x4 a = p[0], b = p[1], c = p[2], d = p[3];
    const float s = ((a[0] + a[1]) + (a[2] + a[3])) + ((b[0] + b[1]) + (b[2] + b[3])) + ((c[0] + c[1]) + (c[2] + c[3])) + ((d[0] + d[1]) + (d[2] + d[3]));
    return __builtin_amdgcn_rsqf(s * (1.0f / D) + EPS);
}

struct EpiQKV {
    static constexpr bool PERM = true;
    bf16_t* O; const float* bias; const float* ssq;
    __device__ __forceinline__ void operator()(const f32x4 (&acc)[2][2][4][2], const Unit& u, int wr, int wc, int fr, int fq) const {
        const int row0 = u.pm * BM + wr * 64 + fr, col0 = u.pn * BM + wc * 32 + 8 * fq;
        const float sc = u.pn < 4 ? QSCALE : 1.0f;
        f32x4 bv[2][2];
#pragma unroll
        for (int bj = 0; bj < 2; ++bj)
#pragma unroll
            for (int n = 0; n < 2; ++n) bv[bj][n] = *(const f32x4*)(bias + col0 + bj * HALF + 4 * n);
#pragma unroll
        for (int ai = 0; ai < 2; ++ai)
#pragma unroll
            for (int m = 0; m < 4; ++m) {
                const int row = row0 + ai * HALF + m * 16; const float rs = rstd_of(ssq, row);
                bf16_t* rowp = O + (size_t)row * NQKV + col0;
#pragma unroll
                for (int bj = 0; bj < 2; ++bj) {
                    const f32x4 v0 = (acc[ai][bj][m][0] * rs + bv[bj][0]) * sc, v1 = (acc[ai][bj][m][1] * rs + bv[bj][1]) * sc;
                    u32x4 w; w.x = cvtpk(v0[0], v0[1]); w.y = cvtpk(v0[2], v0[3]); w.z = cvtpk(v1[0], v1[1]); w.w = cvtpk(v1[2], v1[3]);
                    *(u32x4*)(rowp + bj * HALF) = w;
                }
            }
    }
};
__device__ __forceinline__ float silu_mul(float g, float u) { return g * __builtin_amdgcn_rcpf(1.0f + __builtin_amdgcn_exp2f(-g * LOG2E)) * u; }
struct EpiSwiGLU {
    static constexpr bool PERM = true;
    bf16_t* O; const float* ssq;
    __device__ __forceinline__ void operator()(const f32x4 (&acc)[2][2][4][2], const Unit& u, int wr, int wc, int fr, int fq) const {
        const int row0 = u.pm * BM + wr * 64 + fr, col0 = u.pn * HALF + wc * 32 + 8 * fq;
#pragma unroll
        for (int ai = 0; ai < 2; ++ai)
#pragma unroll
            for (int m = 0; m < 4; ++m) {
                const int row = row0 + ai * HALF + m * 16; const float rs = rstd_of(ssq, row);
                const f32x4 g0 = acc[ai][0][m][0] * rs, g1 = acc[ai][0][m][1] * rs, u0 = acc[ai][1][m][0] * rs, u1 = acc[ai][1][m][1] * rs;
                u32x4 w; w.x = cvtpk(silu_mul(g0[0], u0[0]), silu_mul(g0[1], u0[1])); w.y = cvtpk(silu_mul(g0[2], u0[2]), silu_mul(g0[3], u0[3]));
                w.z = cvtpk(silu_mul(g1[0], u1[0]), silu_mul(g1[1], u1[1])); w.w = cvtpk(silu_mul(g1[2], u1[2]), silu_mul(g1[3], u1[3]));
                *(u32x4*)(O + (size_t)row * FF + col0) = w;
            }
    }
};
struct EpiConvIn {
    static constexpr bool PERM = true;
    bf16_t* GB; bf16_t* Z; const float* ssq;
    __device__ __forceinline__ void operator()(const f32x4 (&acc)[2][2][4][2], const Unit& u, int wr, int wc, int fr, int fq) const {
        const int row0 = u.pm * BM + wr * 64 + fr;
        if (u.pn < 4) {
            const int col0 = u.pn * BM + wc * 32 + 8 * fq;
#pragma unroll
            for (int ai = 0; ai < 2; ++ai)
#pragma unroll
                for (int m = 0; m < 4; ++m) {
                    const int row = row0 + ai * HALF + m * 16; const float rs = rstd_of(ssq, row);
                    bf16_t* rowp = GB + (size_t)row * D + col0;
#pragma unroll
                    for (int bj = 0; bj < 2; ++bj) {
                        const f32x4 v0 = acc[ai][bj][m][0] * rs, v1 = acc[ai][bj][m][1] * rs;
                        u32x4 w; w.x = cvtpk(v0[0], v0[1]); w.y = cvtpk(v0[2], v0[3]); w.z = cvtpk(v1[0], v1[1]); w.w = cvtpk(v1[2], v1[3]);
                        *(u32x4*)(rowp + bj * HALF) = w;
                    }
                }
        } else {
            const int col0 = (u.pn - 4) * HALF + wc * 32 + 8 * fq;
#pragma unroll
            for (int ai = 0; ai < 2; ++ai)
#pragma unroll
                for (int m = 0; m < 4; ++m) {
                    const int row = row0 + ai * HALF + m * 16; const float rs = rstd_of(ssq, row); const float r2 = rs * rs;
                    const f32x4 z0 = acc[ai][0][m][0] * acc[ai][1][m][0] * r2, z1 = acc[ai][0][m][1] * acc[ai][1][m][1] * r2;
                    u32x4 w; w.x = cvtpk(z0[0], z0[1]); w.y = cvtpk(z0[2], z0[3]); w.z = cvtpk(z1[0], z1[1]); w.w = cvtpk(z1[2], z1[3]);
                    *(u32x4*)(Z + (size_t)row * D + col0) = w;
                }
        }
    }
};
struct EpiResid {
    static constexpr bool PERM = false;
    const float* base_real; const float* base_meta; float* out_real; float* out_meta; bf16_t* HB; float* ssq; const float* bias; const float* cscale;
    __device__ __forceinline__ void operator()(const f32x4 (&acc)[2][2][4][2], const Unit& u, int wr, int wc, int fr, int fq) const {
        const int col0 = u.pn * BM + wc * 32 + 4 * fq;
        const bool meta = u.pm >= 64;
        const float* base = meta ? base_meta - (size_t)MR * D : base_real;
        float* out = meta ? out_meta - (size_t)MR * D : out_real;
        f32x4 bv[2][2], cs[2][2];
#pragma unroll
        for (int bj = 0; bj < 2; ++bj)
#pragma unroll
            for (int n = 0; n < 2; ++n) {
                bv[bj][n] = bias ? *(const f32x4*)(bias + col0 + bj * HALF + n * 16) : (f32x4){0.f, 0.f, 0.f, 0.f};
                cs[bj][n] = cscale ? *(const f32x4*)(cscale + col0 + bj * HALF + n * 16) : (f32x4){1.f, 1.f, 1.f, 1.f};
            }
#pragma unroll
        for (int ai = 0; ai < 2; ++ai)
#pragma unroll
            for (int m = 0; m < 4; ++m) {
                const int row = u.pm * BM + ai * HALF + wr * 64 + m * 16 + fr; const size_t off = (size_t)row * D + col0;
                float q = 0.f;
#pragma unroll
                for (int bj = 0; bj < 2; ++bj)
#pragma unroll
                    for (int n = 0; n < 2; ++n) {
                        const f32x4 bs = *(const f32x4*)(base + off + bj * HALF + n * 16);
                        const f32x4 v = bs + (acc[ai][bj][m][n] + bv[bj][n]) * cs[bj][n];
                        *(f32x4*)(out + off + bj * HALF + n * 16) = v;
                        u32x2 w; w.x = cvtpk(v[0], v[1]); w.y = cvtpk(v[2], v[3]);
                        *(u32x2*)(HB + off + bj * HALF + n * 16) = w;
                        q += (v[0] * v[0] + v[1] * v[1]) + (v[2] * v[2] + v[3] * v[3]);
                    }
                q += __shfl_xor(q, 16); q += __shfl_xor(q, 32);
                if (fq == 0) ssq[(size_t)row * 16 + u.pn * 4 + wc] = q;
            }
    }
};

template <class Epi>
__device__ __forceinline__ void gemm_phase(LAS unsigned char* lds, const Gemm g, const StaticOrder& S, const Epi& E, const int tid) {
    const int wid = __builtin_amdgcn_readfirstlane(tid >> 6), lane = tid & 63, wr = wid >> 2, wc = wid & 3, fr = lane & 15, fq = lane >> 4;
    const int K = g.K, nt = K / BK;
    unsigned voffA[2], voffB[2];
#pragma unroll
    for (int i = 0; i < 2; ++i) { int R, C; stage_rc(tid * 16 + i * 8192, R, C); const int Rb = Epi::PERM ? ((R & ~31) + perm32(R & 31)) : R;
        voffA[i] = (unsigned)(R * g.lda + C) * 2u; voffB[i] = (unsigned)(Rb * g.ldb + C) * 2u; }
    const size_t kstep = (size_t)(BK * 2);
    const size_t hstepA = (size_t)HALF * g.lda * 2, hstepB = (size_t)HALF * g.ldb * 2;
    const size_t tstepA = 2 * hstepA, tstepB = 2 * hstepB;
    const size_t pnoffA = (size_t)g.a_pn_off * 2;
    const unsigned ldsw = (unsigned)wid * 1024u;
    const int aoff = lds_byte(wr * 64 + fr, fq * 8), boff = lds_byte(wc * 32 + fr, fq * 8);
#define PG8_SA(b, h) (((b) * 2 + (h)) * HTB)
#define PG8_SB(b, h) ((4 + (b) * 2 + (h)) * HTB)
#define PG8_STAGE(bufoff, gbase, voff) do { _Pragma("unroll") for (int _i = 0; _i < 2; ++_i) \
        __builtin_amdgcn_global_load_lds((const unsigned*)((const char*)(gbase) + (voff)[_i]), (LAS unsigned*)(lds + (bufoff) + ldsw + _i * 8192), 16, 0, 0); } while (0)
#define PG8_LDA(dst, b, h) do { _Pragma("unroll") for (int m = 0; m < 4; ++m) _Pragma("unroll") for (int k = 0; k < 2; ++k) dst[m][k] = *(const LAS bf16x8*)(lds + PG8_SA(b, h) + aoff + m * 2048 + k * 1024); } while (0)
#define PG8_LDB(dst, b, h) do { _Pragma("unroll") for (int n = 0; n < 2; ++n) _Pragma("unroll") for (int k = 0; k < 2; ++k) dst[n][k] = *(const LAS bf16x8*)(lds + PG8_SB(b, h) + boff + n * 2048 + k * 1024); } while (0)
#define PG8_MMA(ai, bj, At, Bt) do { __builtin_amdgcn_s_setprio(1); _Pragma("unroll") for (int m = 0; m < 4; ++m) _Pragma("unroll") for (int n = 0; n < 2; ++n) _Pragma("unroll") for (int k = 0; k < 2; ++k) \
        acc[ai][bj][m][n] = __builtin_amdgcn_mfma_f32_16x16x32_bf16(Bt[n][k], At[m][k], acc[ai][bj][m][n], 0, 0, 0); __builtin_amdgcn_s_setprio(0); } while (0)
#define PG8_WAIT_V(n) asm volatile("s_waitcnt vmcnt(" #n ")" ::: "memory")
#define PG8_WAIT_L(n) asm volatile("s_waitcnt lgkmcnt(" #n ")" ::: "memory")
#define PG8_BAR __builtin_amdgcn_s_barrier()
#define PG8_SCHED __builtin_amdgcn_sched_barrier(0)
    Unit cur, nxt; int ui = 0;
    if (!S.next(0, cur)) return;
    f32x4 acc[2][2][4][2];
#pragma unroll
    for (int a = 0; a < 2; ++a)
#pragma unroll
        for (int b = 0; b < 2; ++b)
#pragma unroll
            for (int m = 0; m < 4; ++m)
#pragma unroll
                for (int n = 0; n < 2; ++n) acc[a][b][m][n] = (f32x4){0.f, 0.f, 0.f, 0.f};
    bf16x8 At[4][2], B0[2][2], B1[2][2];
    const char* cA = (const char*)g.A + (size_t)cur.pm * tstepA + (size_t)cur.pn * pnoffA; const char* cB = (const char*)g.Bt + (size_t)cur.pn * tstepB;
    PG8_STAGE(PG8_SB(0, 0), cB, voffB); PG8_STAGE(PG8_SB(0, 1), cB + hstepB, voffB); PG8_STAGE(PG8_SA(0, 0), cA, voffA); PG8_STAGE(PG8_SA(0, 1), cA + hstepA, voffA);
    if (wr == 1) PG8_BAR;
    PG8_WAIT_V(2); PG8_BAR;
    PG8_STAGE(PG8_SB(1, 0), cB + kstep, voffB); PG8_STAGE(PG8_SA(1, 0), cA + kstep, voffA); PG8_STAGE(PG8_SB(1, 1), cB + hstepB + kstep, voffB);
    PG8_WAIT_V(6); PG8_BAR;
    for (;;) {
        const bool has_next = S.next(ui + 1, nxt);
        const char* nA = has_next ? (const char*)g.A + (size_t)nxt.pm * tstepA + (size_t)nxt.pn * pnoffA : cA; const char* nB = has_next ? (const char*)g.Bt + (size_t)nxt.pn * tstepB : cB;
        for (int t = 0; t < nt; t += 2) {
            const bool last = (t == nt - 2);
            const char* a1 = cA + (size_t)(t + 1) * kstep;
            const char* a2 = last ? nA : cA + (size_t)(t + 2) * kstep; const char* b2 = last ? nB : cB + (size_t)(t + 2) * kstep;
            const char* a3 = a2 + kstep; const char* b3 = b2 + kstep;
            PG8_LDB(B0, 0, 0); PG8_LDB(B1, 0, 1); PG8_SCHED; PG8_LDA(At, 0, 0); PG8_STAGE(PG8_SA(1, 1), a1 + hstepA, voffA);
            PG8_WAIT_V(8); PG8_WAIT_L(0); PG8_BAR; PG8_MMA(0, 0, At, B0); PG8_MMA(0, 1, At, B1); PG8_BAR; PG8_SCHED;
            PG8_LDA(At, 0, 1); PG8_STAGE(PG8_SB(0, 0), b2, voffB); PG8_STAGE(PG8_SB(0, 1), b2 + hstepB, voffB); PG8_STAGE(PG8_SA(0, 0), a2, voffA);
            PG8_WAIT_V(8); PG8_WAIT_L(0); PG8_BAR; PG8_MMA(1, 0, At, B0); PG8_MMA(1, 1, At, B1); PG8_BAR; PG8_SCHED;
            PG8_LDB(B0, 1, 0); PG8_LDB(B1, 1, 1); PG8_SCHED; PG8_LDA(At, 1, 0); PG8_STAGE(PG8_SA(0, 1), a2 + hstepA, voffA);
            PG8_WAIT_V(8); PG8_WAIT_L(0); PG8_BAR; PG8_MMA(0, 0, At, B0); PG8_MMA(0, 1, At, B1); PG8_BAR; PG8_SCHED;
            PG8_LDA(At, 1, 1); PG8_STAGE(PG8_SB(1, 0), b3, voffB); PG8_STAGE(PG8_SB(1, 1), b3 + hstepB, voffB); PG8_STAGE(PG8_SA(1, 0), a3, voffA);
            PG8_WAIT_V(8); PG8_WAIT_L(0); PG8_BAR; PG8_MMA(1, 0, At, B0); PG8_MMA(1, 1, At, B1); PG8_BAR; PG8_SCHED;
        }
        if (wr == 0) PG8_BAR;
        E(acc, cur, wr, wc, fr, fq);
        if (!has_next) break;
#pragma unroll
        for (int a = 0; a < 2; ++a)
#pragma unroll
            for (int b = 0; b < 2; ++b)
#pragma unroll
                for (int m = 0; m < 4; ++m)
#pragma unroll
                    for (int n = 0; n < 2; ++n) acc[a][b][m][n] = (f32x4){0.f, 0.f, 0.f, 0.f};
        cur = nxt; cA = nA; cB = nB; ++ui;
        if (wr == 1) PG8_BAR;
    }
    PG8_WAIT_V(0);
    PG8_BAR;
#undef PG8_SA
#undef PG8_SB
#undef PG8_STAGE
#undef PG8_LDA
#undef PG8_LDB
#undef PG8_MMA
#undef PG8_WAIT_V
#undef PG8_WAIT_L
#undef PG8_BAR
#undef PG8_SCHED
}
}

namespace att {
constexpr int R = 288;
constexpr int K_OFF = 0, K_BYTES = 8 * R * 16, V_OFF = K_BYTES, V_BYTES = 2 * R * 64, TB_OFF = V_OFF + V_BYTES, TOTAL = TB_OFF + 4 * 256 * 4;
static_assert(TOTAL <= RING_BYTES, "attention LDS");
__device__ __forceinline__ s16x4 vtr(const LAS unsigned char* p) { return __builtin_amdgcn_ds_read_tr16_b64_v4i16((LAS s16x4*)p); }

template <int NT, bool META>
__device__ __forceinline__ void group(const LAS unsigned char* lds, const bf16_t* qkv, bf16_t* o, float sink2, int b, int kvh, int nblk, int g, int qs, int lane) {
    const int q = lane & 31, hi = lane >> 5, hq = 4 * kvh + g;
    int row; if (META) row = MR + b * NMETA + (q < NMETA ? q : NMETA - 1); else row = b * S + nblk * 128 + 32 * qs + q;
    bf16x8 qf[4];
#pragma unroll
    for (int ds = 0; ds < 4; ++ds) qf[ds] = *(const bf16x8*)(qkv + (size_t)row * NQKV + hq * 64 + 16 * ds + 8 * hi);
    f32x16 sc[NT];
#pragma unroll
    for (int ti = 0; ti < NT; ++ti) {
        const int rb = ti == 0 ? 0 : 32 * (qs + ti);
        f32x16 a = {};
#pragma unroll
        for (int ds = 0; ds < 4; ++ds) { const bf16x8 kf = *(const LAS bf16x8*)(lds + K_OFF + (2 * ds + hi) * (R * 16) + (rb + q) * 16); a = __builtin_amdgcn_mfma_f32_32x32x16_bf16(kf, qf[ds], a, 0, 0, 0); }
        sc[ti] = a;
    }
    const LAS float* tb = (const LAS float*)(lds + TB_OFF) + g * 256;
    float mx = sink2;
    int base[16];
#pragma unroll
    for (int r = 0; r < 16; ++r) base[r] = (r & 3) + 8 * (r >> 2) + 4 * hi - q;
#pragma unroll
    for (int ti = 0; ti < NT; ++ti) {
        if (ti == 0) {
#pragma unroll
            for (int r = 0; r < 16; ++r) {
                float v = -1e30f;
                if (r < 8) {
                    const int kk = (r & 3) + 8 * (r >> 2) + 4 * hi;
                    if (META) { v = kk <= q ? sc[0][r] + tb[(q - kk) & 255] : -1e30f; }
                    else { int dist = NMETA + nblk * 128 + 32 * qs + q - kk; dist = dist > 255 ? 255 : dist; v = sc[0][r] + tb[dist]; }
                }
                sc[0][r] = v; mx = fmaxf(mx, v);
            }
        } else {
            const bool tile_ok = nblk > 0 || qs + ti - 1 >= 4;
#pragma unroll
            for (int r = 0; r < 16; ++r) {
                const float bias = tb[128 - 32 * (ti - 1) - base[r]];
                bool valid = tile_ok;
                if (ti == 1) valid = valid && base[r] >= 1;
                if (ti == 5) valid = valid && base[r] <= 0;
                const float v = valid ? sc[ti][r] + bias : -1e30f; sc[ti][r] = v; mx = fmaxf(mx, v);
            }
        }
    }
    mx = fmaxf(mx, __shfl_xor(mx, 32));
    float ls = 0.f;
#pragma unroll
    for (int ti = 0; ti < NT; ++ti)
#pragma unroll
        for (int r = 0; r < 16; ++r) { const float p = __builtin_amdgcn_exp2f(sc[ti][r] - mx); sc[ti][r] = p; ls += p; }
    ls += __shfl_xor(ls, 32); ls += __builtin_amdgcn_exp2f(sink2 - mx);
    f32x16 oT[2]; oT[0] = f32x16{}; oT[1] = f32x16{};
#pragma unroll
    for (int ti = 0; ti < NT; ++ti) {
        const int rb = ti == 0 ? 0 : 32 * (qs + ti);
#pragma unroll
        for (int s = 0; s < 2; ++s) {
            u32x4 pw; pw.x = cvtpk(sc[ti][8 * s + 0], sc[ti][8 * s + 1]); pw.y = cvtpk(sc[ti][8 * s + 2], sc[ti][8 * s + 3]); pw.z = cvtpk(sc[ti][8 * s + 4], sc[ti][8 * s + 5]); pw.w = cvtpk(sc[ti][8 * s + 6], sc[ti][8 * s + 7]);
            const bf16x8 pf = __builtin_bit_cast(bf16x8, pw);
#pragma unroll
            for (int dt = 0; dt < 2; ++dt) {
                const LAS unsigned char* vp = lds + V_OFF + dt * (R * 64) + (rb + 16 * s + 4 * hi + ((lane & 15) >> 2)) * 64 + ((lane >> 4) & 1) * 32 + (lane & 3) * 8;
                const s16x4 lo = vtr(vp), h4 = vtr(vp + 512);
                const bf16x8 vf = (bf16x8){lo[0], lo[1], lo[2], lo[3], h4[0], h4[1], h4[2], h4[3]};
                oT[dt] = __builtin_amdgcn_mfma_f32_32x32x16_bf16(vf, pf, oT[dt], 0, 0, 0);
            }
        }
    }
    const float inv = 1.0f / ls;
    if (!META || q < NMETA) {
#pragma unroll
        for (int dt = 0; dt < 2; ++dt)
#pragma unroll
            for (int rg = 0; rg < 4; ++rg) {
                u32x2 w; w.x = cvtpk(oT[dt][4 * rg + 0] * inv, oT[dt][4 * rg + 1] * inv); w.y = cvtpk(oT[dt][4 * rg + 2] * inv, oT[dt][4 * rg + 3] * inv);
                *(u32x2*)(o + (size_t)row * D + hq * 64 + 32 * dt + 8 * rg + 4 * hi) = w;
            }
    }
}

__device__ __forceinline__ void unit(LAS unsigned char* lds, const bf16_t* qkv, bf16_t* o, const float* TBg, const float* sinks, int b, int kvh, int nblk, int tid) {
    asm volatile("" : "+v"(tid));
    const int lane = tid & 63, wid = __builtin_amdgcn_readfirstlane(tid >> 6);
#pragma unroll
    for (int i = 0; i < 9; ++i) {
        const int task = tid + NTHR * i, isv = task >= 8 * R ? 1 : 0, rem = task - isv * 8 * R, row = rem >> 3, ch = rem & 7;
        int grow = -1;
        if (row < 32) { if (row < NMETA) grow = MR + b * NMETA + row; }
        else { const int jk = row - 32; if (nblk < 64 && (nblk > 0 || jk >= 128)) grow = b * S + (nblk - 1) * 128 + jk; }
        u32x4 v = (u32x4){0u, 0u, 0u, 0u};
        if (grow >= 0) v = *(const u32x4*)(qkv + (size_t)grow * NQKV + 1024 + isv * 256 + kvh * 64 + ch * 8);
        const int dst = isv ? V_OFF + (ch >> 2) * (R * 64) + row * 64 + (ch & 3) * 16 : K_OFF + ch * (R * 16) + row * 16;
        *(LAS u32x4*)(lds + dst) = v;
    }
    { LAS float* tb = (LAS float*)(lds + TB_OFF); tb[tid] = TBg[(size_t)(4 * kvh) * 256 + tid]; tb[tid + 512] = TBg[(size_t)(4 * kvh) * 256 + tid + 512]; }
    __syncthreads();
    const int g = wid >> 1;
    const float sink2 = sinks[4 * kvh + g] * LOG2E;
    if (nblk < 64) {
#pragma unroll 1
        for (int i = 0; i < 2; ++i) group<6, false>(lds, qkv, o, sink2, b, kvh, nblk, g, 2 * (wid & 1) + i, lane);
    } else if ((wid & 1) == 0) {
        group<1, true>(lds, qkv, o, sink2, b, kvh, nblk, g, 0, lane);
    }
    __syncthreads();
}
}

#define XB_TMO      128
#define XB_XCNT(j)  (256  + 64 * (j))
#define XB_XSUB(j)  (1280 + 64 * (j))
#define XB_XGEN(j)  (2304 + 64 * (j))
#define XB_TOP      3328
#define XB_TOPGEN   3392
#define XCD_BAR_WORDS 3456
#define XB_SPIN_CAP (1u << 18)
__device__ __forceinline__ unsigned xb_ld(unsigned* p)              { return __hip_atomic_load(p, __ATOMIC_RELAXED, __HIP_MEMORY_SCOPE_AGENT); }
__device__ __forceinline__ unsigned xb_add(unsigned* p, unsigned v) { return __hip_atomic_fetch_add(p, v, __ATOMIC_RELAXED, __HIP_MEMORY_SCOPE_AGENT); }
__device__ __forceinline__ unsigned xb_xcc_id() { return (unsigned)__builtin_amdgcn_s_getreg((3 << 11) | 20) & 0xFu; }
#define XB_SPIN(cond, bar) do { unsigned _sp = 0; while (cond) { __builtin_amdgcn_s_sleep(1); \
    if ((++_sp & 255u) == 0u) { if (xb_ld(&(bar)[XB_TMO])) break; if (_sp > XB_SPIN_CAP) { atomicAdd(&(bar)[XB_TMO], 1u); break; } } } } while (0)
struct XcdBarrier { unsigned* bar; unsigned x; volatile LAS unsigned* st; };
__device__ __forceinline__ XcdBarrier xcd_barrier_post(unsigned* bar, volatile LAS unsigned* st) {
    XcdBarrier b; b.bar = bar; b.x = xb_xcc_id(); b.st = st;
    if (threadIdx.x == 0) (void)xb_add(&bar[XB_XCNT(b.x)], 1u);
    return b;
}
__device__ __forceinline__ void xcd_barrier_complete(unsigned* bar, unsigned x, unsigned& nloc, unsigned& nx) {
    const unsigned G = gridDim.x * gridDim.y * gridDim.z;
    unsigned sum, cnt, mine, sp = 0u;
    for (;;) {
        sum = 0u; cnt = 0u; mine = 0u;
#pragma unroll
        for (unsigned j = 0; j < 16; ++j) { const unsigned c = xb_ld(&bar[XB_XCNT(j)]); sum += c; cnt += (c > 0u) ? 1u : 0u; mine = (j == x) ? c : mine; }
        if (sum == G) break;
        __builtin_amdgcn_s_sleep(1);
        if ((++sp & 255u) == 0u) { if (xb_ld(&bar[XB_TMO])) break; if (sp > XB_SPIN_CAP) { atomicAdd(&bar[XB_TMO], 1u); break; } }
    }
    nloc = mine > 0u ? mine : 1u; nx = cnt > 0u ? cnt : 1u;
}
__device__ __forceinline__ void xcd_barrier(const XcdBarrier& b) {
    asm volatile("s_waitcnt vmcnt(0)" ::: "memory");
    __syncthreads();
    if (threadIdx.x == 0) {
        unsigned* bar = b.bar;
        __builtin_amdgcn_s_waitcnt(0);
        unsigned nloc = b.st[0], nx = b.st[1];
        if (nloc == 0u) { xcd_barrier_complete(bar, b.x, nloc, nx); b.st[0] = nloc; b.st[1] = nx; }
        const unsigned old = xb_add(&bar[XB_XSUB(b.x)], 1u);
        const unsigned gen = old / nloc;
        if (old + 1u == (gen + 1u) * nloc) {
            __builtin_amdgcn_fence(__ATOMIC_RELEASE, "agent");
            asm volatile("s_waitcnt vmcnt(0)" ::: "memory");
            const unsigned og = xb_add(&bar[XB_TOP], 1u);
            const unsigned tg = og / nx;
            if (og + 1u == (tg + 1u) * nx) xb_add(&bar[XB_TOPGEN], 1u);
            else XB_SPIN(xb_ld(&bar[XB_TOPGEN]) == tg, bar);
            __builtin_amdgcn_fence(__ATOMIC_ACQUIRE, "agent");
            xb_add(&bar[XB_XGEN(b.x)], 1u);
            asm volatile("s_waitcnt vmcnt(0)" ::: "memory");
        } else {
            XB_SPIN(xb_ld(&bar[XB_XGEN(b.x)]) == gen, bar);
            __builtin_amdgcn_fence(__ATOMIC_ACQUIRE, "agent");
            asm volatile("s_waitcnt vmcnt(0)" ::: "memory");
        }
    }
    __syncthreads();
}

__device__ __forceinline__ void transpose_item(const float* W, int N, bf16_t* WT, int ldt, int k0, int n0, int drow0, const float* gain, LAS float* scr, int lane) {
#pragma unroll 8
    for (int i = 0; i < 32; ++i) { const int kk = 2 * i + (lane >> 5); float w = W[(size_t)(k0 + kk) * N + n0 + (lane & 31)]; if (gain) w *= gain[k0 + kk]; scr[kk * 33 + (lane & 31)] = w; }
    LDS_WAIT(); asm volatile("" ::: "memory");
    const int c = lane & 7;
#pragma unroll
    for (int j = 0; j < 4; ++j) { const int n = (lane >> 3) + 8 * j; const LAS float* s = scr + (8 * c) * 33 + n;
        u32x4 o; o.x = cvtpk(s[0 * 33], s[1 * 33]); o.y = cvtpk(s[2 * 33], s[3 * 33]); o.z = cvtpk(s[4 * 33], s[5 * 33]); o.w = cvtpk(s[6 * 33], s[7 * 33]);
        *(u32x4*)(WT + (size_t)(drow0 + n) * ldt + k0 + 8 * c) = o; }
    LDS_WAIT(); asm volatile("" ::: "memory");
}

struct Args { const float* in[19]; float* out; unsigned char* ws; int ph_lo, ph_hi; };
constexpr int N_PHASES = 21;

__global__ void __launch_bounds__(NTHR, 2) mega_fwd(Args args) {
    extern __shared__ __attribute__((aligned(16))) unsigned char lds_raw[];
    LAS unsigned char* lds = (LAS unsigned char*)lds_raw;
    const int G = gridDim.x, bx = blockIdx.x;
    const int vcu = (G % 8 == 0) ? (bx % 8) * (G / 8) + bx / 8 : bx;
    for (int u = threadIdx.x; u < (LDS_BYTES - LDSCTL_OFF) / 4; u += NTHR) ((LAS unsigned*)(lds + LDSCTL_OFF))[u] = 0u;
    __syncthreads();
    XcdBarrier bar; bar.bar = (unsigned*)(args.ws + WS_CTL) + CW_BAR; bar.x = 0; bar.st = nullptr;
    if (MK_N_LAUNCHES == 1) bar = xcd_barrier_post((unsigned*)(args.ws + WS_CTL) + CW_BAR, (volatile LAS unsigned*)(lds + MISC_OFF) + 8);

    for (int ph = args.ph_lo; ph < args.ph_hi; ++ph) {
        int tid = threadIdx.x; asm volatile("" : "+v"(tid));
        unsigned long long zoff = 0; asm volatile("" : "+s"(zoff));
        unsigned char* ws = args.ws + zoff;
        const int lane = tid & 63, wave = __builtin_amdgcn_readfirstlane(tid >> 6);
        const float* x = args.in[0]; const float* meta_tok = args.in[1]; const float* rel_table = args.in[2];
        const float* norm_mix = args.in[3]; const float* norm_ffn = args.in[4]; const float* norm_final = args.in[5];
        const float* bqkv = args.in[7]; const float* bo = args.in[9]; const float* sinks = args.in[10];
        const float* conv_w = args.in[12]; const float* pool_scale = args.in[15];
        float* dout = args.out;
        float* hmeta = (float*)(ws + WS_HMETA); float* ssq = (float*)(ws + WS_SSQ); float* TB = (float*)(ws + WS_TB);
        bf16_t* HB = (bf16_t*)(ws + WS_HB); unsigned char* wts = ws + WS_W; unsigned char* big = ws + WS_BIG;
        const int gw = vcu * NWAVES + wave, NGW = G * NWAVES;
        const int gtid = vcu * NTHR + tid, NGT = G * NTHR;
        if (ph == 0) {
            LAS float* scr = (LAS float*)(lds + wave * 16384);
            constexpr int I_ATT = 768 + 512, I_CONV = 1536 + 512, I_POOL = 128, I_FFN = 3 * 1408, NITEMS = 2 * I_ATT + I_CONV + I_POOL + 4 * I_FFN;
            for (int it = gw; it < NITEMS; it += NGW) {
                int r = it;
                if (r < 2 * I_ATT) {
                    const int j = r / I_ATT; r -= j * I_ATT; unsigned char* wl = wts + j * W_ATT_STRIDE;
                    if (r < 768) { const int kb = r / 48, nb = r % 48; transpose_item(args.in[6] + (size_t)j * D * NQKV, NQKV, (bf16_t*)(wl + W_QKV), D, 64 * kb, 32 * nb, 32 * nb, norm_mix + (size_t)(3 * j) * D, scr, lane); }
                    else { r -= 768; const int kb = r / 32, nb = r % 32; transpose_item(args.in[8] + (size_t)j * D * D, D, (bf16_t*)(wl + W_O), D, 64 * kb, 32 * nb, 32 * nb, nullptr, scr, lane); }
                    continue;
                }
                r -= 2 * I_ATT;
                if (r < I_CONV) {
                    if (r < 1536) { const int kb = r / 96, nb = r % 96, n0 = 32 * nb; int drow;
                        if (n0 < 1024) drow = n0; else { const int c = (n0 - 1024) & 1023, isu = n0 >= 2048 ? 1 : 0; drow = 1024 + 256 * (c >> 7) + 128 * isu + (c & 127); }
                        transpose_item(args.in[11], 3 * D, (bf16_t*)(wts + W_CIN), D, 64 * kb, n0, drow, norm_mix + (size_t)1 * D, scr, lane); }
                    else { r -= 1536; const int kb = r / 32, nb = r % 32; transpose_item(args.in[13], D, (bf16_t*)(wts + W_COUT), D, 64 * kb, 32 * nb, 32 * nb, nullptr, scr, lane); }
                    continue;
                }
                r -= I_CONV;
                if (r < I_POOL) { const int gi = r / 32; r -= gi * 32; const int kb = r / 8, nb = r % 8;
                    transpose_item(args.in[14] + (size_t)gi * 256 * 256, 256, (bf16_t*)(wts + W_POOL), 256, 64 * kb, 32 * nb, gi * 256 + 32 * nb, nullptr, scr, lane); continue; }
                r -= I_POOL;
                { const int i = r / I_FFN; r -= i * I_FFN; unsigned char* wl = wts + W_FFN + i * W_FFN_STRIDE;
                  if (r < 2816) { const int isu = r >= 1408 ? 1 : 0; r -= isu * 1408; const int kb = r / 88, nb = r % 88, n0 = 32 * nb;
                      transpose_item(args.in[16 + isu] + (size_t)i * D * FF, FF, (bf16_t*)(wl + W_GU), D, 64 * kb, n0, 256 * (n0 >> 7) + 128 * isu + (n0 & 127), norm_ffn + (size_t)i * D, scr, lane); }
                  else { r -= 2816; const int kb = r / 32, nb = r % 32; transpose_item(args.in[18] + (size_t)i * FF * D, D, (bf16_t*)(wl + W_DN), FF, 64 * kb, 32 * nb, 32 * nb, nullptr, scr, lane); } }
            }
            for (int i = gtid; i < NH * 256; i += NGT) { const int h = i >> 8, dist = i & 255; TB[i] = rel_table[bucket_of(dist) * NH + h] * LOG2E; }
            for (int r = gw; r < MT; r += NGW) {
                const float* src = r < MR ? x + (size_t)r * D : meta_tok + (size_t)((r - MR) & (NMETA - 1)) * D;
                const f32x4* xr = (const f32x4*)src + lane; f32x4 v[4]; float s = 0.f;
#pragma unroll
                for (int j = 0; j < 4; ++j) { v[j] = xr[64 * j]; s += (v[j][0] * v[j][0] + v[j][1] * v[j][1]) + (v[j][2] * v[j][2] + v[j][3] * v[j][3]); }
                s = wave_sum(s);
                u32x2* o8 = (u32x2*)(HB + (size_t)r * D) + lane;
#pragma unroll
                for (int j = 0; j < 4; ++j) { u32x2 w; w.x = cvtpk(v[j][0], v[j][1]); w.y = cvtpk(v[j][2], v[j][3]); o8[64 * j] = w; }
                if (r >= MR) { f32x4* hm = (f32x4*)(hmeta + (size_t)(r - MR) * D) + lane;
#pragma unroll
                    for (int j = 0; j < 4; ++j) hm[64 * j] = v[j]; }
                if (lane < 16) ssq[(size_t)r * 16 + lane] = lane == 0 ? s : 0.f;
            }
        } else if (ph == 20) {
            for (int r = gw; r < MR; r += NGW) {
                float p = lane < 16 ? ssq[(size_t)r * 16 + lane] : 0.f; p = wave_sum(p);
                const float rs = 1.0f / sqrtf(p * (1.0f / D) + EPS);
                f32x4* xr = (f32x4*)(dout + (size_t)r * D) + lane; const f32x4* gr = (const f32x4*)norm_final + lane;
#pragma unroll
                for (int j = 0; j < 4; ++j) { f32x4 v = xr[64 * j]; const f32x4 gg = gr[64 * j]; xr[64 * j] = v * rs * gg; }
            }
        } else {
            const int li = ph <= 5 ? 0 : (ph <= 10 ? 1 : (ph <= 14 ? 2 : 3));
            const int first = li == 0 ? 1 : (li == 1 ? 6 : (li == 2 ? 11 : 15));
            const int last = li == 0 ? 5 : (li == 1 ? 10 : (li == 2 ? 14 : 19));
            unsigned char* wffn = wts + W_FFN + li * W_FFN_STRIDE;
            if (ph == last - 1) {
                pg8::Gemm g{HB, (const bf16_t*)(wffn + W_GU), D, D, D, 0}; pg8::StaticOrder So; So.init(65, 22, G, bx);
                pg8::EpiSwiGLU E{(bf16_t*)big, ssq};
                pg8::gemm_phase<pg8::EpiSwiGLU>(lds, g, So, E, tid);
            } else if (ph == last) {
                pg8::Gemm g{(const bf16_t*)big, (const bf16_t*)(wffn + W_DN), FF, FF, FF, 0}; pg8::StaticOrder So; So.init(65, 4, G, bx);
                pg8::EpiResid E{dout, hmeta, dout, hmeta, HB, ssq, nullptr, nullptr};
                pg8::gemm_phase<pg8::EpiResid>(lds, g, So, E, tid);
            } else if (li == 0 || li == 3) {
                const int j = li == 0 ? 0 : 1; unsigned char* wl = wts + j * W_ATT_STRIDE;
                bf16_t* qkv = (bf16_t*)(big + BIG_QKV); bf16_t* ob = (bf16_t*)(big + BIG_O);
                if (ph == first) {
                    pg8::Gemm g{HB, (const bf16_t*)(wl + W_QKV), D, D, D, 0}; pg8::StaticOrder So; So.init(65, 6, G, bx);
                    pg8::EpiQKV E{qkv, bqkv + (size_t)j * NQKV, ssq};
                    pg8::gemm_phase<pg8::EpiQKV>(lds, g, So, E, tid);
                } else if (ph == first + 1) {
                    for (int ui = vcu; ui < NB * NKV * 65; ui += G) {
                        const int nblk = ui % 65, bk = ui / 65;
                        att::unit(lds, qkv, ob, TB, sinks + (size_t)j * NH, bk >> 2, bk & 3, nblk, tid);
                    }
                } else {
                    pg8::Gemm g{ob, (const bf16_t*)(wl + W_O), D, D, D, 0}; pg8::StaticOrder So; So.init(65, 4, G, bx);
                    pg8::EpiResid E{li == 0 ? x : dout, hmeta, dout, hmeta, HB, ssq, bo + (size_t)j * D, nullptr};
                    pg8::gemm_phase<pg8::EpiResid>(lds, g, So, E, tid);
                }
            } else if (li == 1) {
                bf16_t* GBb = (bf16_t*)(big + BIG_GB); bf16_t* Zb = (bf16_t*)(big + BIG_Z); bf16_t* Gb = (bf16_t*)(big + BIG_G);
                if (ph == first) {
                    pg8::Gemm g{HB, (const bf16_t*)(wts + W_CIN), D, D, D, 0}; pg8::StaticOrder So; So.init(65, 12, G, bx);
                    pg8::EpiConvIn E{GBb, Zb, ssq};
                    pg8::gemm_phase<pg8::EpiConvIn>(lds, g, So, E, tid);
                } else if (ph == first + 1) {
                    for (int it = gtid; it < MT * 128; it += NGT) {
                        const int r = it >> 7, c8 = (it & 127) * 8;
                        int r1, r2;
                        if (r < MR) { const int s = r & (S - 1), b = r >> 13; r1 = s >= 1 ? r - 1 : MR + b * NMETA + 15; r2 = s >= 2 ? r - 2 : MR + b * NMETA + 14 + s; }
                        else { const int m = (r - MR) & 15; r1 = m >= 1 ? r - 1 : -1; r2 = m >= 2 ? r - 2 : -1; }
                        const u32x4 z0 = *(const u32x4*)(Zb + (size_t)r * D + c8);
                        u32x4 z1 = (u32x4){0u, 0u, 0u, 0u}, z2 = (u32x4){0u, 0u, 0u, 0u};
                        if (r1 >= 0) z1 = *(const u32x4*)(Zb + (size_t)r1 * D + c8);
                        if (r2 >= 0) z2 = *(const u32x4*)(Zb + (size_t)r2 * D + c8);
                        const u32x4 gb = *(const u32x4*)(GBb + (size_t)r * D + c8);
                        const float* w0 = conv_w + c8; const float* w1 = conv_w + D + c8; const float* w2 = conv_w + 2 * D + c8;
                        u32x4 ov;
#pragma unroll
                        for (int e = 0; e < 4; ++e) {
                            const unsigned a0 = z0[e], a1 = z1[e], a2 = z2[e], ag = gb[e];
                            const float lo = bf2f((unsigned short)(ag & 0xffffu)) * (w2[2 * e] * bf2f((unsigned short)(a0 & 0xffffu)) + w1[2 * e] * bf2f((unsigned short)(a1 & 0xffffu)) + w0[2 * e] * bf2f((unsigned short)(a2 & 0xffffu)));
                            const float hi = bf2f((unsigned short)(ag >> 16)) * (w2[2 * e + 1] * bf2f((unsigned short)(a0 >> 16)) + w1[2 * e + 1] * bf2f((unsigned short)(a1 >> 16)) + w0[2 * e + 1] * bf2f((unsigned short)(a2 >> 16)));
                            ov[e] = cvtpk(lo, hi);
                        }
                        *(u32x4*)(Gb + (size_t)r * D + c8) = ov;
                    }
                } else {
                    pg8::Gemm g{Gb, (const bf16_t*)(wts + W_COUT), D, D, D, 0}; pg8::StaticOrder So; So.init(65, 4, G, bx);
                    pg8::EpiResid E{dout, hmeta, dout, hmeta, HB, ssq, nullptr, nullptr};
                    pg8::gemm_phase<pg8::EpiResid>(lds, g, So, E, tid);
                }
            } else {
                bf16_t* MIX = (bf16_t*)big;
                if (ph == first) {
                    LAS float* rsl = (LAS float*)lds;
                    const float* gmix = norm_mix + (size_t)2 * D;
                    for (int ui = vcu; ui < NB * 129; ui += G) {
                        const int b = ui / 129, t0 = (ui % 129) * 64;
                        __syncthreads();
                        if (tid < 79) { const int t = t0 - 15 + tid; float rs = 0.f;
                            if (t >= 0 && t < LSEQ) { const int row = rowof(b, t); const f32x4* p = (const f32x4*)(ssq + (size_t)row * 16); const f32x4 a = p[0], bb = p[1], c = p[2], d = p[3];
                                const float s = ((a[0] + a[1]) + (a[2] + a[3])) + ((bb[0] + bb[1]) + (bb[2] + bb[3])) + ((c[0] + c[1]) + (c[2] + c[3])) + ((d[0] + d[1]) + (d[2] + d[3]));
                                rs = 1.0f / sqrtf(s * (1.0f / D) + EPS); }
                            rsl[tid] = rs; }
                        __syncthreads();
                        const int c = 2 * tid, win = 2 << (c >> 8);
                        const f32x2 gg = *(const f32x2*)(gmix + c);
#define POOL_A(t) ({ const int _t = (t); f32x2 _a = (f32x2){0.f, 0.f}; if (_t >= 0) { const int _row = rowof(b, _t); const float* _hp = _row < MR ? dout + (size_t)_row * D : hmeta + (size_t)(_row - MR) * D; \
                            const f32x2 _h = *(const f32x2*)(_hp + c); const float _rs = rsl[_t - (t0 - 15)]; _a = _h * _rs * gg; } _a; })
                        f32x2 Ssum = (f32x2){0.f, 0.f};
                        for (int jj = 1; jj < win; ++jj) Ssum += POOL_A(t0 - jj);
                        const int tend = t0 + 64 < LSEQ ? t0 + 64 : LSEQ;
                        for (int t = t0; t < tend; ++t) {
                            const f32x2 at = POOL_A(t); Ssum += at;
                            const int cnt = win < t + 1 ? win : t + 1; const float ic = 1.0f / (float)cnt;
                            const f32x2 mx = Ssum * ic - at;
                            *(unsigned*)(MIX + (size_t)rowof(b, t) * D + c) = cvtpk(mx[0], mx[1]);
                            Ssum -= POOL_A(t - win + 1);
                        }
#undef POOL_A
                    }
                    __syncthreads();
                } else {
                    pg8::Gemm g{MIX, (const bf16_t*)(wts + W_POOL), D, 256, 256, 256}; pg8::StaticOrder So; So.init(65, 4, G, bx);
                    pg8::EpiResid E{dout, hmeta, dout, hmeta, HB, ssq, nullptr, pool_scale};
                    pg8::gemm_phase<pg8::EpiResid>(lds, g, So, E, tid);
                }
            }
        }
        if (MK_N_LAUNCHES == 1 && ph + 1 < args.ph_hi) xcd_barrier(bar);
    }
}

extern "C" void kernel_launch(void* const* d_in, const int* in_sizes, int n_in, void* d_out, int out_size, void* d_ws, size_t ws_size, hipStream_t stream) {
    static int grid = 0;
    if (grid == 0) {
        if (n_in != 19 || out_size != MR * D || ws_size < WS_END) { fprintf(stderr, "kernel_launch: unexpected shapes (n_in %d out %d ws %zu)\n", n_in, out_size, ws_size); grid = -1; return; }
        int dev = 0, cus = 0, per_cu = 0;
        if (hipGetDevice(&dev) != hipSuccess || hipDeviceGetAttribute(&cus, hipDeviceAttributeMultiprocessorCount, dev) != hipSuccess) { grid = -1; return; }
        if (hipFuncSetAttribute((const void*)mega_fwd, hipFuncAttributeMaxDynamicSharedMemorySize, LDS_BYTES) != hipSuccess) { fprintf(stderr, "kernel_launch: hipFuncSetAttribute failed\n"); grid = -1; return; }
        if (hipOccupancyMaxActiveBlocksPerMultiprocessor(&per_cu, (const void*)mega_fwd, NTHR, LDS_BYTES) != hipSuccess || per_cu < 1) { fprintf(stderr, "kernel_launch: occupancy query says %d blocks/CU\n", per_cu); }
        (void)hipGetLastError();
        grid = cus;
    }
    if (grid < 0) return;
    if (hipMemsetAsync((char*)d_ws + WS_CTL, 0, CTL_ZERO_BYTES, stream) != hipSuccess) { fprintf(stderr, "kernel_launch: memset failed\n"); return; }
    Args a{};
    for (int i = 0; i < 19; ++i) a.in[i] = (const float*)d_in[i];
    a.out = (float*)d_out; a.ws = (unsigned char*)d_ws;
    if (MK_N_LAUNCHES == 1) {
        a.ph_lo = 0; a.ph_hi = N_PHASES;
        hipLaunchKernelGGL(mega_fwd, dim3(grid), dim3(NTHR), LDS_BYTES, stream, a);
    } else {
        for (int ph = 0; ph < N_PHASES; ++ph) { a.ph_lo = ph; a.ph_hi = ph + 1; hipLaunchKernelGGL(mega_fwd, dim3(grid), dim3(NTHR), LDS_BYTES, stream, a); }
    }
}
```

```cpp
#include <hip/hip_runtime.h>
#include <cstdio>
#include <cstdint>

#ifndef MK_N_LAUNCHES
#define MK_N_LAUNCHES 1
#endif
#ifndef PROBE_MASK
#define PROBE_MASK 0u
#endif
#ifndef PROBE_XBAR
#define PROBE_XBAR 0
#endif

#define LAS __attribute__((address_space(3)))
#define GAS __attribute__((address_space(1)))
typedef unsigned short bf16_t;
typedef short bf16x8 __attribute__((ext_vector_type(8)));
typedef short s16x4 __attribute__((ext_vector_type(4)));
typedef float f32x2 __attribute__((ext_vector_type(2)));
typedef float f32x4 __attribute__((ext_vector_type(4)));
typedef float f32x16 __attribute__((ext_vector_type(16)));
typedef unsigned u32x2 __attribute__((ext_vector_type(2)));
typedef unsigned u32x4 __attribute__((ext_vector_type(4)));
typedef __bf16 bf16x2_t __attribute__((ext_vector_type(2)));

constexpr int D = 1024, NB = 2, S = 8192, NMETA = 16, LSEQ = S + NMETA;
constexpr int MR = NB * S;
constexpr int MT = MR + NMETA;
constexpr int MP = 65 * 256;
constexpr int NH = 16, NKV = 4, HD = 64, NQKV = 1536, FF = 2816;
constexpr float EPS = 1e-6f;
constexpr float LOG2E = 1.4426950408889634f;
constexpr float QSCALE = 0.125f * LOG2E;
constexpr int NWAVES = 8, NTHR = 512;

constexpr size_t MiB = 1u << 20;
constexpr size_t WS_CTL = 0, CTL_ZERO_BYTES = 1 * MiB;
constexpr size_t WS_HMETA = 1 * MiB;
constexpr size_t WS_SSQ = 2 * MiB;
constexpr size_t WS_SSQM = 3 * MiB + 512 * 1024;
constexpr size_t WS_TB = 4 * MiB;
constexpr size_t WS_W = 5 * MiB;
constexpr size_t W_QKV = 0, W_O = 3 * MiB, W_ATT_STRIDE = 5 * MiB;
constexpr size_t W_CIN = 10 * MiB, W_COUT = 16 * MiB, W_POOL = 18 * MiB;
constexpr size_t W_FFN = 19 * MiB, W_FFN_STRIDE = 33 * MiB / 2, W_GU = 0, W_DN = 11 * MiB;
constexpr size_t WS_HB = 90 * MiB;
constexpr size_t WS_BIG = 123 * MiB;
constexpr size_t BIG_QKV = 0, BIG_O = 49 * MiB;
constexpr size_t BIG_GB = 0, BIG_Z = 33 * MiB, BIG_G = 66 * MiB;
constexpr size_t WS_END = 256 * MiB;
static_assert(W_FFN + 4 * W_FFN_STRIDE <= 85 * MiB && WS_W + 85 * MiB <= WS_HB, "weights");
static_assert(WS_HB + (size_t)MP * D * 2 <= WS_BIG && WS_BIG + (size_t)MP * FF * 2 <= WS_END, "ws map");

constexpr int CW_BAR = 4096;

constexpr int RING_BYTES = 131072;
constexpr int LDSCTL_OFF = RING_BYTES, MISC_OFF = LDSCTL_OFF + 320;
constexpr int LDS_BYTES = 147456;

__device__ __forceinline__ unsigned cvtpk(float lo, float hi) { f32x2 v = {lo, hi}; bf16x2_t b = __builtin_convertvector(v, bf16x2_t); return __builtin_bit_cast(unsigned, b); }
__device__ __forceinline__ float bf2f(unsigned short u) { return __builtin_bit_cast(float, (unsigned)u << 16); }
__device__ __forceinline__ float wave_sum(float v) {
#pragma unroll
    for (int o = 1; o < 64; o <<= 1) v += __shfl_xor(v, o);
    return v;
}
__device__ __forceinline__ int rowof(int b, int t) { return t < NMETA ? MR + t : b * S + (t - NMETA); }
__device__ __forceinline__ int bucket_of(int dist) {
    if (dist < 16) return dist < 0 ? 0 : dist;
    int v = 16 + (int)(log2f((float)dist * 0.0625f) * (16.0f / 3.0f));
    return v > 31 ? 31 : v;
}
#define LDS_WAIT() asm volatile("s_waitcnt lgkmcnt(0)" ::: "memory")
#define VM_WAIT() asm volatile("s_waitcnt vmcnt(0)" ::: "memory")

namespace pg8 {
constexpr int BM = 256, BK = 64, HALF = 128, HTB = HALF * BK * 2, STAGE_BYTES = 8 * HTB, NXCD = 8, WGM = 8;
__host__ __device__ __forceinline__ int lds_byte(int r, int c) { const int st = (r >> 4) * 2 + (c >> 5), rr = r & 15, cc = c & 31, ob = rr * 64 + cc * 2; return st * 1024 + (ob ^ (((ob >> 9) & 1) << 5)); }
__host__ __device__ __forceinline__ void stage_rc(int b, int& R, int& C) { const int st = b / 1024, sb = b % 1024, swz = sb ^ (((sb >> 9) & 1) << 5); R = (st >> 1) * 16 + swz / 64; C = (st & 1) * 32 + (swz % 64) / 2; }
__host__ __device__ __forceinline__ int perm32(int rho) { const int n = rho >> 4, i = rho & 15; return 8 * (i >> 2) + 4 * n + (i & 3); }

struct Unit { int pm, pn; };
struct Gemm { const bf16_t* A; const bf16_t* Bt; int lda, ldb, K, a_pn_off; };

struct StaticOrder {
    int nM, nN, nwg, G, c;
    __device__ void init(int nM_, int nN_, int G_, int c_) { nM = nM_; nN = nN_; nwg = nM * nN; G = G_; c = c_; }
    __device__ bool next(int i, Unit& u) const {
        const long L = (long)i * G + c; if (L >= nwg) return false;
        int wgid = (int)L; { const int q = nwg / NXCD, r = nwg % NXCD, xcd = wgid % NXCD, off = wgid / NXCD; wgid = (xcd < r ? xcd * (q + 1) : r * (q + 1) + (xcd - r) * q) + off; }
        const int nig = WGM * nN, gid = wgid / nig, fm = gid * WGM, gsz = (nM - fm) < WGM ? (nM - fm) : WGM;
        u.pm = fm + ((wgid % nig) % gsz); u.pn = (wgid % nig) / gsz; return true;
    }
};

__device__ __forceinline__ float rstd_of(const float* ssq, int row) {
    const f32x4* p = (const f32x4*)(ssq + (size_t)row * 16);
    const f32x4 a = p[0], b = p[1], c = p[2], d = p[3];
    const float s = ((a[0] + a[1]) + (a[2] + a[3])) + ((b[0] + b[1]) + (b[2] + b[3])) + ((c[0] + c[1]) + (c[2] + c[3])) + ((d[0] + d[1]) + (d[2] + d[3]));
    return __builtin_amdgcn_rsqf(s * (1.0f / D) + EPS);
}

struct EpiQKV {
    static constexpr bool PERM = true;
    bf16_t* O; const float* bias; const float* ssq;
    __device__ __forceinline__ void operator()(const f32x4 (&acc)[2][2][4][2], const Unit& u, int wr, int wc, int fr, int fq) const {
        const int row0 = u.pm * BM + wr * 64 + fr, col0 = u.pn * BM + wc * 32 + 8 * fq;
        const float sc = u.pn < 4 ? QSCALE : 1.0f;
        f32x4 bv[2][2];
#pragma unroll
        for (int bj = 0; bj < 2; ++bj)
#pragma unroll
            for (int n = 0; n < 2; ++n) bv[bj][n] = *(const f32x4*)(bias + col0 + bj * HALF + 4 * n);
#pragma unroll
        for (int ai = 0; ai < 2; ++ai)
#pragma unroll
            for (int m = 0; m < 4; ++m) {
                const int row = row0 + ai * HALF + m * 16; const float rs = rstd_of(ssq, row);
                bf16_t* rowp = O + (size_t)row * NQKV + col0;
#pragma unroll
                for (int bj = 0; bj < 2; ++bj) {
                    const f32x4 v0 = (acc[ai][bj][m][0] * rs + bv[bj][0]) * sc, v1 = (acc[ai][bj][m][1] * rs + bv[bj][1]) * sc;
                    u32x4 w; w.x = cvtpk(v0[0], v0[1]); w.y = cvtpk(v0[2], v0[3]); w.z = cvtpk(v1[0], v1[1]); w.w = cvtpk(v1[2], v1[3]);
                    *(u32x4*)(rowp + bj * HALF) = w;
                }
            }
    }
};
__device__ __forceinline__ float silu_mul(float g, float u) { return g * __builtin_amdgcn_rcpf(1.0f + __builtin_amdgcn_exp2f(-g * LOG2E)) * u; }
struct EpiSwiGLU {
    static constexpr bool PERM = true;
    bf16_t* O; const float* ssq;
    __device__ __forceinline__ void operator()(const f32x4 (&acc)[2][2][4][2], const Unit& u, int wr, int wc, int fr, int fq) const {
        const int row0 = u.pm * BM + wr * 64 + fr, col0 = u.pn * HALF + wc * 32 + 8 * fq;
#pragma unroll
        for (int ai = 0; ai < 2; ++ai)
#pragma unroll
            for (int m = 0; m < 4; ++m) {
                const int row = row0 + ai * HALF + m * 16; const float rs = rstd_of(ssq, row);
                const f32x4 g0 = acc[ai][0][m][0] * rs, g1 = acc[ai][0][m][1] * rs, u0 = acc[ai][1][m][0] * rs, u1 = acc[ai][1][m][1] * rs;
                u32x4 w; w.x = cvtpk(silu_mul(g0[0], u0[0]), silu_mul(g0[1], u0[1])); w.y = cvtpk(silu_mul(g0[2], u0[2]), silu_mul(g0[3], u0[3]));
                w.z = cvtpk(silu_mul(g1[0], u1[0]), silu_mul(g1[1], u1[1])); w.w = cvtpk(silu_mul(g1[2], u1[2]), silu_mul(g1[3], u1[3]));
                *(u32x4*)(O + (size_t)row * FF + col0) = w;
            }
    }
};
struct EpiConvIn {
    static constexpr bool PERM = true;
    bf16_t* GB; bf16_t* Z; const float* ssq;
    __device__ __forceinline__ void operator()(const f32x4 (&acc)[2][2][4][2], const Unit& u, int wr, int wc, int fr, int fq) const {
        const int row0 = u.pm * BM + wr * 64 + fr;
        if (u.pn < 4) {
            const int col0 = u.pn * BM + wc * 32 + 8 * fq;
#pragma unroll
            for (int ai = 0; ai < 2; ++ai)
#pragma unroll
                for (int m = 0; m < 4; ++m) {
                    const int row = row0 + ai * HALF + m * 16; const float rs = rstd_of(ssq, row);
                    bf16_t* rowp = GB + (size_t)row * D + col0;
#pragma unroll
                    for (int bj = 0; bj < 2; ++bj) {
                        const f32x4 v0 = acc[ai][bj][m][0] * rs, v1 = acc[ai][bj][m][1] * rs;
                        u32x4 w; w.x = cvtpk(v0[0], v0[1]); w.y = cvtpk(v0[2], v0[3]); w.z = cvtpk(v1[0], v1[1]); w.w = cvtpk(v1[2], v1[3]);
                        *(u32x4*)(rowp + bj * HALF) = w;
                    }
                }
        } else {
            const int col0 = (u.pn - 4) * HALF + wc * 32 + 8 * fq;
#pragma unroll
            for (int ai = 0; ai < 2; ++ai)
#pragma unroll
                for (int m = 0; m < 4; ++m) {
                    const int row = row0 + ai * HALF + m * 16; const float rs = rstd_of(ssq, row); const float r2 = rs * rs;
                    const f32x4 z0 = acc[ai][0][m][0] * acc[ai][1][m][0] * r2, z1 = acc[ai][0][m][1] * acc[ai][1][m][1] * r2;
                    u32x4 w; w.x = cvtpk(z0[0], z0[1]); w.y = cvtpk(z0[2], z0[3]); w.z = cvtpk(z1[0], z1[1]); w.w = cvtpk(z1[2], z1[3]);
                    *(u32x4*)(Z + (size_t)row * D + col0) = w;
                }
        }
    }
};
struct EpiResid {
    static constexpr bool PERM = false;
    const bf16_t* HBi; bf16_t* HBo; float* fout; float* ssq; const float* bias; const float* cscale; int rmask;
    __device__ __forceinline__ void operator()(const f32x4 (&acc)[2][2][4][2], const Unit& u, int wr, int wc, int fr, int fq) const {
        const int col0 = u.pn * BM + wc * 32 + 4 * fq;
        f32x4 bv[2][2], cs[2][2];
#pragma unroll
        for (int bj = 0; bj < 2; ++bj)
#pragma unroll
            for (int n = 0; n < 2; ++n) {
                bv[bj][n] = bias ? *(const f32x4*)(bias + col0 + bj * HALF + n * 16) : (f32x4){0.f, 0.f, 0.f, 0.f};
                cs[bj][n] = cscale ? *(const f32x4*)(cscale + col0 + bj * HALF + n * 16) : (f32x4){1.f, 1.f, 1.f, 1.f};
            }
        const size_t off0 = (size_t)(u.pm * BM + wr * 64 + fr) * D + col0;
        u32x2 cur[2][2], nxt[2][2];
#pragma unroll
        for (int bj = 0; bj < 2; ++bj)
#pragma unroll
            for (int n = 0; n < 2; ++n) cur[bj][n] = *(const u32x2*)(HBi + off0 + bj * HALF + n * 16);
#pragma unroll
        for (int gi = 0; gi < 8; ++gi) {
            const int ai = gi >> 2, m = gi & 3;
            if (gi < 7) { const size_t offn = off0 + (size_t)(((gi + 1) >> 2) * HALF + ((gi + 1) & 3) * 16) * D;
#pragma unroll
                for (int bj = 0; bj < 2; ++bj)
#pragma unroll
                    for (int n = 0; n < 2; ++n) nxt[bj][n] = *(const u32x2*)(HBi + offn + bj * HALF + n * 16); }
            const int srow = (u.pm * BM + ai * HALF + wr * 64 + m * 16 + fr) & rmask; const size_t soff = (size_t)srow * D + col0;
            float q = 0.f;
#pragma unroll
            for (int bj = 0; bj < 2; ++bj)
#pragma unroll
                for (int n = 0; n < 2; ++n) {
                    const u32x2 hb = cur[bj][n];
                    const f32x4 h4 = (f32x4){__builtin_bit_cast(float, hb.x << 16), __builtin_bit_cast(float, hb.x & 0xffff0000u), __builtin_bit_cast(float, hb.y << 16), __builtin_bit_cast(float, hb.y & 0xffff0000u)};
                    const f32x4 v = h4 + (acc[ai][bj][m][n] + bv[bj][n]) * cs[bj][n];
                    if (fout) *(f32x4*)(fout + soff + bj * HALF + n * 16) = v;
                    u32x2 w; w.x = cvtpk(v[0], v[1]); w.y = cvtpk(v[2], v[3]);
                    *(u32x2*)(HBo + soff + bj * HALF + n * 16) = w;
                    q += (v[0] * v[0] + v[1] * v[1]) + (v[2] * v[2] + v[3] * v[3]);
                }
            q += __shfl_xor(q, 16); q += __shfl_xor(q, 32);
            if (fq == 0) ssq[(size_t)srow * 16 + u.pn * 4 + wc] = q;
#pragma unroll
            for (int bj = 0; bj < 2; ++bj)
#pragma unroll
                for (int n = 0; n < 2; ++n) cur[bj][n] = nxt[bj][n];
        }
    }
};

template <class Epi>
__device__ __forceinline__ void gemm_phase(LAS unsigned char* lds, const Gemm g, const StaticOrder& S, const Epi& E, const int tid) {
    const int wid = __builtin_amdgcn_readfirstlane(tid >> 6), lane = tid & 63, wr = wid >> 2, wc = wid & 3, fr = lane & 15, fq = lane >> 4;
    const int K = g.K, nt = K / BK;
    unsigned voffA[2], voffB[2];
#pragma unroll
    for (int i = 0; i < 2; ++i) { int R, C; stage_rc(tid * 16 + i * 8192, R, C); const int Rb = Epi::PERM ? ((R & ~31) + perm32(R & 31)) : R;
        voffA[i] = (unsigned)(R * g.lda + C) * 2u; voffB[i] = (unsigned)(Rb * g.ldb + C) * 2u; }
    const size_t kstep = (size_t)(BK * 2);
    const size_t hstepA = (size_t)HALF * g.lda * 2, hstepB = (size_t)HALF * g.ldb * 2;
    const size_t tstepA = 2 * hstepA, tstepB = 2 * hstepB;
    const size_t pnoffA = (size_t)g.a_pn_off * 2;
    const unsigned ldsw = (unsigned)wid * 1024u;
    const int aoff = lds_byte(wr * 64 + fr, fq * 8), boff = lds_byte(wc * 32 + fr, fq * 8);
#define PG8_SA(b, h) (((b) * 2 + (h)) * HTB)
#define PG8_SB(b, h) ((4 + (b) * 2 + (h)) * HTB)
#define PG8_STAGE(bufoff, gbase, voff) do { _Pragma("unroll") for (int _i = 0; _i < 2; ++_i) \
        __builtin_amdgcn_global_load_lds((const unsigned*)((const char*)(gbase) + (voff)[_i]), (LAS unsigned*)(lds + (bufoff) + ldsw + _i * 8192), 16, 0, 0); } while (0)
#define PG8_LDA(dst, b, h) do { _Pragma("unroll") for (int m = 0; m < 4; ++m) _Pragma("unroll") for (int k = 0; k < 2; ++k) dst[m][k] = *(const LAS bf16x8*)(lds + PG8_SA(b, h) + aoff + m * 2048 + k * 1024); } while (0)
#define PG8_LDB(dst, b, h) do { _Pragma("unroll") for (int n = 0; n < 2; ++n) _Pragma("unroll") for (int k = 0; k < 2; ++k) dst[n][k] = *(const LAS bf16x8*)(lds + PG8_SB(b, h) + boff + n * 2048 + k * 1024); } while (0)
#define PG8_MMA(ai, bj, At, Bt) do { __builtin_amdgcn_s_setprio(1); _Pragma("unroll") for (int m = 0; m < 4; ++m) _Pragma("unroll") for (int n = 0; n < 2; ++n) _Pragma("unroll") for (int k = 0; k < 2; ++k) \
        acc[ai][bj][m][n] = __builtin_amdgcn_mfma_f32_16x16x32_bf16(Bt[n][k], At[m][k], acc[ai][bj][m][n], 0, 0, 0); __builtin_amdgcn_s_setprio(0); } while (0)
#define PG8_WAIT_V(n) asm volatile("s_waitcnt vmcnt(" #n ")" ::: "memory")
#define PG8_WAIT_L(n) asm volatile("s_waitcnt lgkmcnt(" #n ")" ::: "memory")
#define PG8_BAR __builtin_amdgcn_s_barrier()
#define PG8_SCHED __builtin_amdgcn_sched_barrier(0)
    Unit cur, nxt; int ui = 0;
    if (!S.next(0, cur)) return;
    f32x4 acc[2][2][4][2];
#pragma unroll
    for (int a = 0; a < 2; ++a)
#pragma unroll
        for (int b = 0; b < 2; ++b)
#pragma unroll
            for (int m = 0; m < 4; ++m)
#pragma unroll
                for (int n = 0; n < 2; ++n) acc[a][b][m][n] = (f32x4){0.f, 0.f, 0.f, 0.f};
    bf16x8 At[4][2], B0[2][2], B1[2][2];
    const char* cA = (const char*)g.A + (size_t)cur.pm * tstepA + (size_t)cur.pn * pnoffA; const char* cB = (const char*)g.Bt + (size_t)cur.pn * tstepB;
    PG8_STAGE(PG8_SB(0, 0), cB, voffB); PG8_STAGE(PG8_SB(0, 1), cB + hstepB, voffB); PG8_STAGE(PG8_SA(0, 0), cA, voffA); PG8_STAGE(PG8_SA(0, 1), cA + hstepA, voffA);
    if (wr == 1) PG8_BAR;
    PG8_WAIT_V(2); PG8_BAR;
    PG8_STAGE(PG8_SB(1, 0), cB + kstep, voffB); PG8_STAGE(PG8_SA(1, 0), cA + kstep, voffA); PG8_STAGE(PG8_SB(1, 1), cB + hstepB + kstep, voffB);
    PG8_WAIT_V(6); PG8_BAR;
    for (;;) {
        const bool has_next = S.next(ui + 1, nxt);
        const char* nA = has_next ? (const char*)g.A + (size_t)nxt.pm * tstepA + (size_t)nxt.pn * pnoffA : cA; const char* nB = has_next ? (const char*)g.Bt + (size_t)nxt.pn * tstepB : cB;
        for (int t = 0; t < nt; t += 2) {
            const bool last = (t == nt - 2);
            const char* a1 = cA + (size_t)(t + 1) * kstep;
            const char* a2 = last ? nA : cA + (size_t)(t + 2) * kstep; const char* b2 = last ? nB : cB + (size_t)(t + 2) * kstep;
            const char* a3 = a2 + kstep; const char* b3 = b2 + kstep;
            PG8_LDB(B0, 0, 0); PG8_LDB(B1, 0, 1); PG8_SCHED; PG8_LDA(At, 0, 0); PG8_STAGE(PG8_SA(1, 1), a1 + hstepA, voffA);
            PG8_WAIT_V(8); PG8_WAIT_L(0); PG8_BAR; PG8_MMA(0, 0, At, B0); PG8_MMA(0, 1, At, B1); PG8_BAR; PG8_SCHED;
            PG8_LDA(At, 0, 1); PG8_STAGE(PG8_SB(0, 0), b2, voffB); PG8_STAGE(PG8_SB(0, 1), b2 + hstepB, voffB); PG8_STAGE(PG8_SA(0, 0), a2, voffA);
            PG8_WAIT_V(8); PG8_WAIT_L(0); PG8_BAR; PG8_MMA(1, 0, At, B0); PG8_MMA(1, 1, At, B1); PG8_BAR; PG8_SCHED;
            PG8_LDB(B0, 1, 0); PG8_LDB(B1, 1, 1); PG8_SCHED; PG8_LDA(At, 1, 0); PG8_STAGE(PG8_SA(0, 1), a2 + hstepA, voffA);
            PG8_WAIT_V(8); PG8_WAIT_L(0); PG8_BAR; PG8_MMA(0, 0, At, B0); PG8_MMA(0, 1, At, B1); PG8_BAR; PG8_SCHED;
            PG8_LDA(At, 1, 1); PG8_STAGE(PG8_SB(1, 0), b3, voffB); PG8_STAGE(PG8_SB(1, 1), b3 + hstepB, voffB); PG8_STAGE(PG8_SA(1, 0), a3, voffA);
            PG8_WAIT_V(8); PG8_WAIT_L(0); PG8_BAR; PG8_MMA(1, 0, At, B0); PG8_MMA(1, 1, At, B1); PG8_BAR; PG8_SCHED;
        }
        if (wr == 0) PG8_BAR;
        E(acc, cur, wr, wc, fr, fq);
        if (!has_next) break;
#pragma unroll
        for (int a = 0; a < 2; ++a)
#pragma unroll
            for (int b = 0; b < 2; ++b)
#pragma unroll
                for (int m = 0; m < 4; ++m)
#pragma unroll
                    for (int n = 0; n < 2; ++n) acc[a][b][m][n] = (f32x4){0.f, 0.f, 0.f, 0.f};
        cur = nxt; cA = nA; cB = nB; ++ui;
        if (wr == 1) PG8_BAR;
    }
    PG8_WAIT_V(0);
    PG8_BAR;
#undef PG8_SA
#undef PG8_SB
#undef PG8_STAGE
#undef PG8_LDA
#undef PG8_LDB
#undef PG8_MMA
#undef PG8_WAIT_V
#undef PG8_WAIT_L
#undef PG8_BAR
#undef PG8_SCHED
}
}

namespace att {
constexpr int R = 288;
constexpr int K_OFF = 0, K_BYTES = 8 * R * 16, V_OFF = K_BYTES, V_BYTES = 2 * R * 64, TB_OFF = V_OFF + V_BYTES, TOTAL = TB_OFF + 4 * 256 * 4;
static_assert(TOTAL <= RING_BYTES, "attention LDS");
__device__ __forceinline__ s16x4 vtr(const LAS unsigned char* p) { return __builtin_amdgcn_ds_read_tr16_b64_v4i16((LAS s16x4*)p); }

template <int NT, bool META>
__device__ __forceinline__ void group(const LAS unsigned char* lds, const bf16_t* qkv, bf16_t* o, float sink2, int b, int kvh, int nblk, int g, int qs, int lane) {
    const int q = lane & 31, hi = lane >> 5, hq = 4 * kvh + g;
    int row; if (META) row = MR + (q < NMETA ? q : NMETA - 1); else row = b * S + nblk * 128 + 32 * qs + q;
    bf16x8 qf[4];
#pragma unroll
    for (int ds = 0; ds < 4; ++ds) qf[ds] = *(const bf16x8*)(qkv + (size_t)row * NQKV + hq * 64 + 16 * ds + 8 * hi);
    f32x16 sc[NT];
#pragma unroll
    for (int ti = 0; ti < NT; ++ti) {
        const int rb = ti == 0 ? 0 : 32 * (qs + ti);
        f32x16 a = {};
#pragma unroll
        for (int ds = 0; ds < 4; ++ds) { const bf16x8 kf = *(const LAS bf16x8*)(lds + K_OFF + (2 * ds + hi) * (R * 16) + (rb + q) * 16); a = __builtin_amdgcn_mfma_f32_32x32x16_bf16(kf, qf[ds], a, 0, 0, 0); }
        sc[ti] = a;
    }
    const LAS float* tb = (const LAS float*)(lds + TB_OFF) + g * 256;
    float mx = sink2;
    int base[16];
#pragma unroll
    for (int r = 0; r < 16; ++r) base[r] = (r & 3) + 8 * (r >> 2) + 4 * hi - q;
#pragma unroll
    for (int ti = 0; ti < NT; ++ti) {
        if (ti == 0) {
#pragma unroll
            for (int r = 0; r < 16; ++r) {
                float v = -1e30f;
                if (r < 8) {
                    const int kk = (r & 3) + 8 * (r >> 2) + 4 * hi;
                    if (META) { v = kk <= q ? sc[0][r] + tb[(q - kk) & 255] : -1e30f; }
                    else { int dist = NMETA + nblk * 128 + 32 * qs + q - kk; dist = dist > 255 ? 255 : dist; v = sc[0][r] + tb[dist]; }
                }
                sc[0][r] = v; mx = fmaxf(mx, v);
            }
        } else {
            const bool tile_ok = nblk > 0 || qs + ti - 1 >= 4;
#pragma unroll
            for (int r = 0; r < 16; ++r) {
                const float bias = tb[128 - 32 * (ti - 1) - base[r]];
                bool valid = tile_ok;
                if (ti == 1) valid = valid && base[r] >= 1;
                if (ti == 5) valid = valid && base[r] <= 0;
                const float v = valid ? sc[ti][r] + bias : -1e30f; sc[ti][r] = v; mx = fmaxf(mx, v);
            }
        }
    }
    mx = fmaxf(mx, __shfl_xor(mx, 32));
    float ls = 0.f;
#pragma unroll
    for (int ti = 0; ti < NT; ++ti)
#pragma unroll
        for (int r = 0; r < 16; ++r) { const float p = __builtin_amdgcn_exp2f(sc[ti][r] - mx); sc[ti][r] = p; ls += p; }
    ls += __shfl_xor(ls, 32); ls += __builtin_amdgcn_exp2f(sink2 - mx);
    f32x16 oT[2]; oT[0] = f32x16{}; oT[1] = f32x16{};
#pragma unroll
    for (int ti = 0; ti < NT; ++ti) {
        const int rb = ti == 0 ? 0 : 32 * (qs + ti);
#pragma unroll
        for (int s = 0; s < 2; ++s) {
            u32x4 pw; pw.x = cvtpk(sc[ti][8 * s + 0], sc[ti][8 * s + 1]); pw.y = cvtpk(sc[ti][8 * s + 2], sc[ti][8 * s + 3]); pw.z = cvtpk(sc[ti][8 * s + 4], sc[ti][8 * s + 5]); pw.w = cvtpk(sc[ti][8 * s + 6], sc[ti][8 * s + 7]);
            const bf16x8 pf = __builtin_bit_cast(bf16x8, pw);
#pragma unroll
            for (int dt = 0; dt < 2; ++dt) {
                const LAS unsigned char* vp = lds + V_OFF + dt * (R * 64) + (rb + 16 * s + 4 * hi + ((lane & 15) >> 2)) * 64 + ((lane >> 4) & 1) * 32 + (lane & 3) * 8;
                const s16x4 lo = vtr(vp), h4 = vtr(vp + 512);
                const bf16x8 vf = (bf16x8){lo[0], lo[1], lo[2], lo[3], h4[0], h4[1], h4[2], h4[3]};
                oT[dt] = __builtin_amdgcn_mfma_f32_32x32x16_bf16(vf, pf, oT[dt], 0, 0, 0);
            }
        }
    }
    const float inv = 1.0f / ls;
    if (!META || q < NMETA) {
#pragma unroll
        for (int dt = 0; dt < 2; ++dt)
#pragma unroll
            for (int rg = 0; rg < 4; ++rg) {
                u32x2 w; w.x = cvtpk(oT[dt][4 * rg + 0] * inv, oT[dt][4 * rg + 1] * inv); w.y = cvtpk(oT[dt][4 * rg + 2] * inv, oT[dt][4 * rg + 3] * inv);
                *(u32x2*)(o + (size_t)row * D + hq * 64 + 32 * dt + 8 * rg + 4 * hi) = w;
            }
    }
}

__device__ __forceinline__ void unit(LAS unsigned char* lds, const bf16_t* qkv, bf16_t* o, const float* TBg, const float* sinks, int b, int kvh, int nblk, int tid) {
    asm volatile("" : "+v"(tid));
    const int lane = tid & 63, wid = __builtin_amdgcn_readfirstlane(tid >> 6);
#pragma unroll
    for (int i = 0; i < 9; ++i) {
        const int task = tid + NTHR * i, isv = task >= 8 * R ? 1 : 0, rem = task - isv * 8 * R, row = rem >> 3, ch = rem & 7;
        int grow = -1;
        if (row < 32) { if (row < NMETA) grow = MR + row; }
        else { const int jk = row - 32; if (nblk < 64 && (nblk > 0 || jk >= 128)) grow = b * S + (nblk - 1) * 128 + jk; }
        u32x4 v = (u32x4){0u, 0u, 0u, 0u};
        if (grow >= 0) v = *(const u32x4*)(qkv + (size_t)grow * NQKV + 1024 + isv * 256 + kvh * 64 + ch * 8);
        const int dst = isv ? V_OFF + (ch >> 2) * (R * 64) + row * 64 + (ch & 3) * 16 : K_OFF + ch * (R * 16) + row * 16;
        *(LAS u32x4*)(lds + dst) = v;
    }
    { LAS float* tb = (LAS float*)(lds + TB_OFF); tb[tid] = TBg[(size_t)(4 * kvh) * 256 + tid]; tb[tid + 512] = TBg[(size_t)(4 * kvh) * 256 + tid + 512]; }
    __syncthreads();
    const int g = wid >> 1;
    const float sink2 = sinks[4 * kvh + g] * LOG2E;
    if (nblk < 64) {
#pragma unroll 1
        for (int i = 0; i < 2; ++i) group<6, false>(lds, qkv, o, sink2, b, kvh, nblk, g, 2 * (wid & 1) + i, lane);
    } else if ((wid & 1) == 0) {
        group<1, true>(lds, qkv, o, sink2, b, kvh, nblk, g, 0, lane);
    }
    __syncthreads();
}
}

namespace meta {
__device__ __forceinline__ bf16_t tobf(float v) { return (bf16_t)(cvtpk(v, 0.f) & 0xffffu); }
__device__ __forceinline__ void rstd4(const float* ssqm, int lane, float (&rs)[4]) {
    const f32x4* p = (const f32x4*)(ssqm + (lane & 15) * 64 + (lane >> 4) * 16);
    const f32x4 a = p[0], b = p[1], c = p[2], d = p[3];
    float s = ((a[0] + a[1]) + (a[2] + a[3])) + ((b[0] + b[1]) + (b[2] + b[3])) + ((c[0] + c[1]) + (c[2] + c[3])) + ((d[0] + d[1]) + (d[2] + d[3]));
    s += __shfl_xor(s, 16); s += __shfl_xor(s, 32);
    const float r = __builtin_amdgcn_rsqf(s * (1.0f / D) + EPS);
#pragma unroll
    for (int reg = 0; reg < 4; ++reg) rs[reg] = __shfl(r, 4 * (lane >> 4) + reg);
}
template <int NBF>
__device__ __forceinline__ void mma16(const bf16_t* A, int lda, const bf16_t* B0, const bf16_t* B1, int ldb, int K, f32x4& c0, f32x4& c1, int lane) {
    const int r = lane & 15, kq = lane >> 4;
    const bf16_t* ap = A + (size_t)r * lda + 8 * kq; const bf16_t* bp0 = B0 + (size_t)r * ldb + 8 * kq; const bf16_t* bp1 = B1 + (size_t)r * ldb + 8 * kq;
    for (int k = 0; k < K; k += 256) {
        bf16x8 a[8], b0[8], b1[8];
#pragma unroll
        for (int u = 0; u < 8; ++u) { a[u] = *(const bf16x8*)(ap + k + 32 * u); b0[u] = *(const bf16x8*)(bp0 + k + 32 * u); if (NBF == 2) b1[u] = *(const bf16x8*)(bp1 + k + 32 * u); }
#pragma unroll
        for (int u = 0; u < 8; ++u) { c0 = __builtin_amdgcn_mfma_f32_16x16x32_bf16(a[u], b0[u], c0, 0, 0, 0); if (NBF == 2) c1 = __builtin_amdgcn_mfma_f32_16x16x32_bf16(a[u], b1[u], c1, 0, 0, 0); }
    }
}
__device__ __forceinline__ void task_qkv(int task, const bf16_t* HB, const bf16_t* Wt, const float* bias, const float* ssqm, bf16_t* qkv, int lane) {
    const int n0 = 16 * task; f32x4 c0 = {0.f, 0.f, 0.f, 0.f}, c1 = c0;
    mma16<1>(HB + (size_t)MR * D, D, Wt + (size_t)n0 * D, Wt, D, D, c0, c1, lane);
    float rs[4]; rstd4(ssqm, lane, rs);
    const int n = n0 + (lane & 15); const float bv = bias[n], sc = n0 < 1024 ? QSCALE : 1.0f;
#pragma unroll
    for (int reg = 0; reg < 4; ++reg) { const int row = 4 * (lane >> 4) + reg; qkv[(size_t)(MR + row) * NQKV + n] = tobf((c0[reg] * rs[reg] + bv) * sc); }
}
__device__ __forceinline__ void task_gu(int task, const bf16_t* HB, const bf16_t* Wgu, const float* ssqm, bf16_t* act, int lane) {
    const int c = 16 * task; f32x4 c0 = {0.f, 0.f, 0.f, 0.f}, c1 = c0;
    const bf16_t* B0 = Wgu + (size_t)(256 * (c >> 7) + (c & 127)) * D;
    mma16<2>(HB + (size_t)MR * D, D, B0, B0 + (size_t)128 * D, D, D, c0, c1, lane);
    float rs[4]; rstd4(ssqm, lane, rs);
#pragma unroll
    for (int reg = 0; reg < 4; ++reg) { const int row = 4 * (lane >> 4) + reg; act[(size_t)(MR + row) * FF + c + (lane & 15)] = tobf(pg8::silu_mul(c0[reg] * rs[reg], c1[reg] * rs[reg])); }
}
__device__ __forceinline__ void task_cin(int task, const bf16_t* HB, const bf16_t* Wcin, const float* ssqm, bf16_t* GB, bf16_t* Z, int lane) {
    f32x4 c0 = {0.f, 0.f, 0.f, 0.f}, c1 = c0; float rs[4];
    if (task < 64) {
        const int n0 = 16 * task;
        mma16<1>(HB + (size_t)MR * D, D, Wcin + (size_t)n0 * D, Wcin, D, D, c0, c1, lane);
        rstd4(ssqm, lane, rs);
#pragma unroll
        for (int reg = 0; reg < 4; ++reg) { const int row = 4 * (lane >> 4) + reg; GB[(size_t)(MR + row) * D + n0 + (lane & 15)] = tobf(c0[reg] * rs[reg]); }
    } else {
        const int c = 16 * (task - 64);
        const bf16_t* B0 = Wcin + (size_t)(1024 + 256 * (c >> 7) + (c & 127)) * D;
        mma16<2>(HB + (size_t)MR * D, D, B0, B0 + (size_t)128 * D, D, D, c0, c1, lane);
        rstd4(ssqm, lane, rs);
#pragma unroll
        for (int reg = 0; reg < 4; ++reg) { const int row = 4 * (lane >> 4) + reg; Z[(size_t)(MR + row) * D + c + (lane & 15)] = tobf(c0[reg] * c1[reg] * rs[reg] * rs[reg]); }
    }
}
__device__ __forceinline__ void task_res(int task, const bf16_t* A, int lda, int a_pn_off, const bf16_t* Wt, int ldb, int K, const float* bias, const float* cscale, float* hmeta, bf16_t* HB, float* ssqm, int lane) {
    const int n0 = 16 * task; f32x4 c0 = {0.f, 0.f, 0.f, 0.f}, c1 = c0;
    mma16<1>(A + (size_t)MR * lda + (size_t)(n0 >> 8) * a_pn_off, lda, Wt + (size_t)n0 * ldb, Wt, ldb, K, c0, c1, lane);
    const int n = n0 + (lane & 15); const float bv = bias ? bias[n] : 0.f, cs = cscale ? cscale[n] : 1.0f;
#pragma unroll
    for (int reg = 0; reg < 4; ++reg) {
        const int row = 4 * (lane >> 4) + reg;
        const float v = hmeta[(size_t)row * D + n] + (c0[reg] + bv) * cs;
        hmeta[(size_t)row * D + n] = v; HB[(size_t)(MR + row) * D + n] = tobf(v);
        float q = v * v; q += __shfl_xor(q, 1); q += __shfl_xor(q, 2); q += __shfl_xor(q, 4); q += __shfl_xor(q, 8);
        if ((lane & 15) == 0) ssqm[row * 64 + task] = q;
    }
}
}

#define XB_TMO      128
#define XB_XCNT(j)  (256  + 64 * (j))
#define XB_XSUB(j)  (1280 + 64 * (j))
#define XB_XGEN(j)  (2304 + 64 * (j))
#define XB_TOP      3328
#define XB_TOPGEN   3392
#define XCD_BAR_WORDS 3456
#define XB_SPIN_CAP (1u << 18)
__device__ __forceinline__ unsigned xb_ld(unsigned* p)              { return __hip_atomic_load(p, __ATOMIC_RELAXED, __HIP_MEMORY_SCOPE_AGENT); }
__device__ __forceinline__ unsigned xb_add(unsigned* p, unsigned v) { return __hip_atomic_fetch_add(p, v, __ATOMIC_RELAXED, __HIP_MEMORY_SCOPE_AGENT); }
__device__ __forceinline__ unsigned xb_xcc_id() { return (unsigned)__builtin_amdgcn_s_getreg((3 << 11) | 20) & 0xFu; }
#define XB_SPIN(cond, bar) do { unsigned _sp = 0; while (cond) { __builtin_amdgcn_s_sleep(1); \
    if ((++_sp & 255u) == 0u) { if (xb_ld(&(bar)[XB_TMO])) break; if (_sp > XB_SPIN_CAP) { atomicAdd(&(bar)[XB_TMO], 1u); break; } } } } while (0)
struct XcdBarrier { unsigned* bar; unsigned x; volatile LAS unsigned* st; };
__device__ __forceinline__ XcdBarrier xcd_barrier_post(unsigned* bar, volatile LAS unsigned* st) {
    XcdBarrier b; b.bar = bar; b.x = xb_xcc_id(); b.st = st;
    if (threadIdx.x == 0) (void)xb_add(&bar[XB_XCNT(b.x)], 1u);
    return b;
}
__device__ __forceinline__ void xcd_barrier_complete(unsigned* bar, unsigned x, unsigned& nloc, unsigned& nx) {
    const unsigned G = gridDim.x * gridDim.y * gridDim.z;
    unsigned sum, cnt, mine, sp = 0u;
    for (;;) {
        sum = 0u; cnt = 0u; mine = 0u;
#pragma unroll
        for (unsigned j = 0; j < 16; ++j) { const unsigned c = xb_ld(&bar[XB_XCNT(j)]); sum += c; cnt += (c > 0u) ? 1u : 0u; mine = (j == x) ? c : mine; }
        if (sum == G) break;
        __builtin_amdgcn_s_sleep(1);
        if ((++sp & 255u) == 0u) { if (xb_ld(&bar[XB_TMO])) break; if (sp > XB_SPIN_CAP) { atomicAdd(&bar[XB_TMO], 1u); break; } }
    }
    nloc = mine > 0u ? mine : 1u; nx = cnt > 0u ? cnt : 1u;
}
__device__ __forceinline__ void xcd_barrier(const XcdBarrier& b) {
    asm volatile("s_waitcnt vmcnt(0)" ::: "memory");
    __syncthreads();
    if (threadIdx.x == 0) {
        unsigned* bar = b.bar;
        __builtin_amdgcn_s_waitcnt(0);
        unsigned nloc = b.st[0], nx = b.st[1];
        if (nloc == 0u) { xcd_barrier_complete(bar, b.x, nloc, nx); b.st[0] = nloc; b.st[1] = nx; }
        const unsigned old = xb_add(&bar[XB_XSUB(b.x)], 1u);
        const unsigned gen = old / nloc;
        if (old + 1u == (gen + 1u) * nloc) {
            __builtin_amdgcn_fence(__ATOMIC_RELEASE, "agent");
            asm volatile("s_waitcnt vmcnt(0)" ::: "memory");
            const unsigned og = xb_add(&bar[XB_TOP], 1u);
            const unsigned tg = og / nx;
            if (og + 1u == (tg + 1u) * nx) xb_add(&bar[XB_TOPGEN], 1u);
            else XB_SPIN(xb_ld(&bar[XB_TOPGEN]) == tg, bar);
            __builtin_amdgcn_fence(__ATOMIC_ACQUIRE, "agent");
            xb_add(&bar[XB_XGEN(b.x)], 1u);
            asm volatile("s_waitcnt vmcnt(0)" ::: "memory");
        } else {
            XB_SPIN(xb_ld(&bar[XB_XGEN(b.x)]) == gen, bar);
            __builtin_amdgcn_fence(__ATOMIC_ACQUIRE, "agent");
            asm volatile("s_waitcnt vmcnt(0)" ::: "memory");
        }
    }
    __syncthreads();
}

__device__ __forceinline__ void transpose_item(const float* W, int N, bf16_t* WT, int ldt, int k0, int n0, int drow0, const float* gain, LAS float* scr, int lane) {
#pragma unroll
    for (int i = 0; i < 32; ++i) { const int kk = 2 * i + (lane >> 5); float w = W[(size_t)(k0 + kk) * N + n0 + (lane & 31)]; if (gain) w *= gain[k0 + kk]; scr[kk * 33 + (lane & 31)] = w; }
    LDS_WAIT(); asm volatile("" ::: "memory");
    const int c = lane & 7;
#pragma unroll
    for (int j = 0; j < 4; ++j) { const int n = (lane >> 3) + 8 * j; const LAS float* s = scr + (8 * c) * 33 + n;
        u32x4 o; o.x = cvtpk(s[0 * 33], s[1 * 33]); o.y = cvtpk(s[2 * 33], s[3 * 33]); o.z = cvtpk(s[4 * 33], s[5 * 33]); o.w = cvtpk(s[6 * 33], s[7 * 33]);
        *(u32x4*)(WT + (size_t)(drow0 + n) * ldt + k0 + 8 * c) = o; }
    LDS_WAIT(); asm volatile("" ::: "memory");
}

struct Args { const float* in[19]; float* out; unsigned char* ws; int ph_lo, ph_hi; };
constexpr int N_PHASES = 21;

__global__ void __launch_bounds__(NTHR, 2) mega_fwd(Args args) {
    extern __shared__ __attribute__((aligned(16))) unsigned char lds_raw[];
    LAS unsigned char* lds = (LAS unsigned char*)lds_raw;
    const int G = gridDim.x, bx = blockIdx.x;
    const int vcu = (G % 8 == 0) ? (bx % 8) * (G / 8) + bx / 8 : bx;
    for (int u = threadIdx.x; u < (LDS_BYTES - LDSCTL_OFF) / 4; u += NTHR) ((LAS unsigned*)(lds + LDSCTL_OFF))[u] = 0u;
    __syncthreads();
    XcdBarrier bar; bar.bar = (unsigned*)(args.ws + WS_CTL) + CW_BAR; bar.x = 0; bar.st = nullptr;
    if (MK_N_LAUNCHES == 1) bar = xcd_barrier_post((unsigned*)(args.ws + WS_CTL) + CW_BAR, (volatile LAS unsigned*)(lds + MISC_OFF) + 8);

#define IDS() int tid = threadIdx.x; asm volatile("" : "+v"(tid)); const int lane = tid & 63, wave = __builtin_amdgcn_readfirstlane(tid >> 6); \
    const int gw = vcu * NWAVES + wave, NGW = G * NWAVES, gtid = vcu * NTHR + tid, NGT = G * NTHR, mw = (G - 1 - bx) * NWAVES + wave; \
    (void)lane; (void)gw; (void)NGW; (void)gtid; (void)NGT; (void)mw

    for (int ph = args.ph_lo; ph < args.ph_hi; ++ph) {
        unsigned long long zoff = 0; asm volatile("" : "+s"(zoff));
        unsigned char* ws = args.ws + zoff;
        const float* x = args.in[0]; const float* meta_tok = args.in[1]; const float* rel_table = args.in[2];
        const float* norm_mix = args.in[3]; const float* norm_ffn = args.in[4]; const float* norm_final = args.in[5];
        const float* bqkv = args.in[7]; const float* bo = args.in[9]; const float* sinks = args.in[10];
        const float* conv_w = args.in[12]; const float* pool_scale = args.in[15];
        float* dout = args.out;
        float* hmeta = (float*)(ws + WS_HMETA); float* ssq = (float*)(ws + WS_SSQ); float* ssqm = (float*)(ws + WS_SSQM); float* TB = (float*)(ws + WS_TB);
        bf16_t* HB = (bf16_t*)(ws + WS_HB); unsigned char* wts = ws + WS_W; unsigned char* big = ws + WS_BIG;
        const int nrep = ((PROBE_MASK >> ph) & 1u) ? 2 : 1;
        for (int prep = 0; prep < nrep; ++prep) {
        const bool dry = prep + 1 < nrep;
        bf16_t* r_hb = dry ? (bf16_t*)(ws + 229 * MiB) : HB; float* r_ssq = dry ? (float*)(ws + 237 * MiB) : ssq; const int r_mask = dry ? 4095 : -1;
        float* r_fout = ph == 19 ? (dry ? (float*)(ws + 213 * MiB) : dout) : nullptr;
        if (ph == 0) {
            IDS();
            LAS float* scr = (LAS float*)(lds + wave * 16384);
            constexpr int I_ATT = 768 + 512, I_CONV = 1536 + 512, I_POOL = 128, I_FFN = 3 * 1408, NITEMS = 2 * I_ATT + I_CONV + I_POOL + 4 * I_FFN;
            for (int it = gw; it < NITEMS; it += NGW) {
                int r = it;
                if (r < 2 * I_ATT) {
                    const int j = r / I_ATT; r -= j * I_ATT; unsigned char* wl = wts + j * W_ATT_STRIDE;
                    if (r < 768) { const int kb = r / 48, nb = r % 48; transpose_item(args.in[6] + (size_t)j * D * NQKV, NQKV, (bf16_t*)(wl + W_QKV), D, 64 * kb, 32 * nb, 32 * nb, norm_mix + (size_t)(3 * j) * D, scr, lane); }
                    else { r -= 768; const int kb = r / 32, nb = r % 32; transpose_item(args.in[8] + (size_t)j * D * D, D, (bf16_t*)(wl + W_O), D, 64 * kb, 32 * nb, 32 * nb, nullptr, scr, lane); }
                    continue;
                }
                r -= 2 * I_ATT;
                if (r < I_CONV) {
                    if (r < 1536) { const int kb = r / 96, nb = r % 96, n0 = 32 * nb; int drow;
                        if (n0 < 1024) drow = n0; else { const int c = (n0 - 1024) & 1023, isu = n0 >= 2048 ? 1 : 0; drow = 1024 + 256 * (c >> 7) + 128 * isu + (c & 127); }
                        transpose_item(args.in[11], 3 * D, (bf16_t*)(wts + W_CIN), D, 64 * kb, n0, drow, norm_mix + (size_t)1 * D, scr, lane); }
                    else { r -= 1536; const int kb = r / 32, nb = r % 32; transpose_item(args.in[13], D, (bf16_t*)(wts + W_COUT), D, 64 * kb, 32 * nb, 32 * nb, nullptr, scr, lane); }
                    continue;
                }
                r -= I_CONV;
                if (r < I_POOL) { const int gi = r / 32; r -= gi * 32; const int kb = r / 8, nb = r % 8;
                    transpose_item(args.in[14] + (size_t)gi * 256 * 256, 256, (bf16_t*)(wts + W_POOL), 256, 64 * kb, 32 * nb, gi * 256 + 32 * nb, nullptr, scr, lane); continue; }
                r -= I_POOL;
                { const int i = r / I_FFN; r -= i * I_FFN; unsigned char* wl = wts + W_FFN + i * W_FFN_STRIDE;
                  if (r < 2816) { const int isu = r >= 1408 ? 1 : 0; r -= isu * 1408; const int kb = r / 88, nb = r % 88, n0 = 32 * nb;
                      transpose_item(args.in[16 + isu] + (size_t)i * D * FF, FF, (bf16_t*)(wl + W_GU), D, 64 * kb, n0, 256 * (n0 >> 7) + 128 * isu + (n0 & 127), norm_ffn + (size_t)i * D, scr, lane); }
                  else { r -= 2816; const int kb = r / 32, nb = r % 32; transpose_item(args.in[18] + (size_t)i * FF * D, D, (bf16_t*)(wl + W_DN), FF, 64 * kb, 32 * nb, 32 * nb, nullptr, scr, lane); } }
            }
            for (int i = gtid; i < NH * 256; i += NGT) { const int h = i >> 8, dist = i & 255; TB[i] = rel_table[bucket_of(dist) * NH + h] * LOG2E; }
            for (int r0 = gw * 4; r0 < MT; r0 += NGW * 4) {
                f32x4 v[4][4];
#pragma unroll
                for (int q = 0; q < 4; ++q) { const int r = r0 + q; const float* src = r < MR ? x + (size_t)r * D : meta_tok + (size_t)(r - MR) * D; const f32x4* xr = (const f32x4*)src + lane;
#pragma unroll
                    for (int j = 0; j < 4; ++j) v[q][j] = xr[64 * j]; }
#pragma unroll
                for (int q = 0; q < 4; ++q) { const int r = r0 + q; float s = 0.f;
#pragma unroll
                    for (int j = 0; j < 4; ++j) s += (v[q][j][0] * v[q][j][0] + v[q][j][1] * v[q][j][1]) + (v[q][j][2] * v[q][j][2] + v[q][j][3] * v[q][j][3]);
                    s = wave_sum(s);
                    u32x2* o8 = (u32x2*)(HB + (size_t)r * D) + lane;
#pragma unroll
                    for (int j = 0; j < 4; ++j) { u32x2 w; w.x = cvtpk(v[q][j][0], v[q][j][1]); w.y = cvtpk(v[q][j][2], v[q][j][3]); o8[64 * j] = w; }
                    if (r >= MR) { f32x4* hm = (f32x4*)(hmeta + (size_t)(r - MR) * D) + lane;
#pragma unroll
                        for (int j = 0; j < 4; ++j) hm[64 * j] = v[q][j]; }
                    if (r < MR) { if (lane < 16) ssq[(size_t)r * 16 + lane] = lane == 0 ? s : 0.f; } else ssqm[(r - MR) * 64 + lane] = lane == 0 ? s : 0.f; }
            }
        } else if (ph == 20) {
            IDS();
            for (int r0 = gw * 4; r0 < MR; r0 += NGW * 4) {
                f32x4 v[4][4]; float p[4];
#pragma unroll
                for (int q = 0; q < 4; ++q) { const int r = r0 + q; p[q] = lane < 16 ? ssq[(size_t)r * 16 + lane] : 0.f; const f32x4* xr = (const f32x4*)(dout + (size_t)r * D) + lane;
#pragma unroll
                    for (int j = 0; j < 4; ++j) v[q][j] = xr[64 * j]; }
                const f32x4* gr = (const f32x4*)norm_final + lane; f32x4 gg[4];
#pragma unroll
                for (int j = 0; j < 4; ++j) gg[j] = gr[64 * j];
#pragma unroll
                for (int q = 0; q < 4; ++q) { const float rs = 1.0f / sqrtf(wave_sum(p[q]) * (1.0f / D) + EPS); f32x4* xr = (f32x4*)(dout + (size_t)(r0 + q) * D) + lane;
#pragma unroll
                    for (int j = 0; j < 4; ++j) xr[64 * j] = v[q][j] * rs * gg[j]; }
            }
        } else {
            const int li = ph <= 5 ? 0 : (ph <= 10 ? 1 : (ph <= 14 ? 2 : 3));
            const int first = li == 0 ? 1 : (li == 1 ? 6 : (li == 2 ? 11 : 15));
            const int last = li == 0 ? 5 : (li == 1 ? 10 : (li == 2 ? 14 : 19));
            unsigned char* wffn = wts + W_FFN + li * W_FFN_STRIDE;
            if (ph == last - 1) {
                { IDS(); pg8::Gemm g{HB, (const bf16_t*)(wffn + W_GU), D, D, D, 0}; pg8::StaticOrder So; So.init(64, 22, G, bx);
                  pg8::EpiSwiGLU E{(bf16_t*)big, ssq};
                  pg8::gemm_phase<pg8::EpiSwiGLU>(lds, g, So, E, tid); }
                { IDS(); for (int task = mw; task < 176; task += NGW) meta::task_gu(task, HB, (const bf16_t*)(wffn + W_GU), ssqm, (bf16_t*)big, lane); }
            } else if (ph == last) {
                { IDS(); pg8::Gemm g{(const bf16_t*)big, (const bf16_t*)(wffn + W_DN), FF, FF, FF, 0}; pg8::StaticOrder So; So.init(64, 4, G, bx);
                  pg8::EpiResid E{HB, r_hb, r_fout, r_ssq, nullptr, nullptr, r_mask};
                  pg8::gemm_phase<pg8::EpiResid>(lds, g, So, E, tid); }
                if (!dry) { IDS(); for (int task = mw; task < 64; task += NGW) meta::task_res(task, (const bf16_t*)big, FF, 0, (const bf16_t*)(wffn + W_DN), FF, FF, nullptr, nullptr, hmeta, HB, ssqm, lane); }
            } else if (li == 0 || li == 3) {
                const int j = li == 0 ? 0 : 1; unsigned char* wl = wts + j * W_ATT_STRIDE;
                bf16_t* qkv = (bf16_t*)(big + BIG_QKV); bf16_t* ob = (bf16_t*)(big + BIG_O);
                if (ph == first) {
                    { IDS(); pg8::Gemm g{HB, (const bf16_t*)(wl + W_QKV), D, D, D, 0}; pg8::StaticOrder So; So.init(64, 6, G, bx);
                      pg8::EpiQKV E{qkv, bqkv + (size_t)j * NQKV, ssq};
                      pg8::gemm_phase<pg8::EpiQKV>(lds, g, So, E, tid); }
                    { IDS(); for (int task = mw; task < 96; task += NGW) meta::task_qkv(task, HB, (const bf16_t*)(wl + W_QKV), bqkv + (size_t)j * NQKV, ssqm, qkv, lane); }
                } else if (ph == first + 1) {
                    for (int ui = vcu; ui < NB * NKV * 64 + NKV; ui += G) {
                        const bool mq = ui >= NB * NKV * 64; const int nblk = mq ? 64 : (ui & 63), bk = mq ? (ui - NB * NKV * 64) : (ui >> 6);
                        att::unit(lds, qkv, ob, TB, sinks + (size_t)j * NH, bk >> 2, bk & 3, nblk, threadIdx.x);
                    }
                } else {
                    { IDS(); pg8::Gemm g{ob, (const bf16_t*)(wl + W_O), D, D, D, 0}; pg8::StaticOrder So; So.init(64, 4, G, bx);
                      pg8::EpiResid E{HB, r_hb, nullptr, r_ssq, bo + (size_t)j * D, nullptr, r_mask};
                      pg8::gemm_phase<pg8::EpiResid>(lds, g, So, E, tid); }
                    if (!dry) { IDS(); for (int task = mw; task < 64; task += NGW) meta::task_res(task, ob, D, 0, (const bf16_t*)(wl + W_O), D, D, bo + (size_t)j * D, nullptr, hmeta, HB, ssqm, lane); }
                }
            } else if (li == 1) {
                bf16_t* GBb = (bf16_t*)(big + BIG_GB); bf16_t* Zb = (bf16_t*)(big + BIG_Z); bf16_t* Gb = (bf16_t*)(big + BIG_G);
                if (ph == first) {
                    { IDS(); pg8::Gemm g{HB, (const bf16_t*)(wts + W_CIN), D, D, D, 0}; pg8::StaticOrder So; So.init(64, 12, G, bx);
                      pg8::EpiConvIn E{GBb, Zb, ssq};
                      pg8::gemm_phase<pg8::EpiConvIn>(lds, g, So, E, tid); }
                    { IDS(); for (int task = mw; task < 128; task += NGW) meta::task_cin(task, HB, (const bf16_t*)(wts + W_CIN), ssqm, GBb, Zb, lane); }
                } else if (ph == first + 1) {
                    IDS();
                    for (int it = gtid; it < MT * 128; it += NGT) {
                        const int r = it >> 7, c8 = (it & 127) * 8;
                        int r1, r2;
                        if (r < MR) { const int s = r & (S - 1); r1 = s >= 1 ? r - 1 : MR + 15; r2 = s >= 2 ? r - 2 : MR + 14 + s; }
                        else { const int m = (r - MR) & 15; r1 = m >= 1 ? r - 1 : -1; r2 = m >= 2 ? r - 2 : -1; }
                        const u32x4 z0 = *(const u32x4*)(Zb + (size_t)r * D + c8);
                        u32x4 z1 = (u32x4){0u, 0u, 0u, 0u}, z2 = (u32x4){0u, 0u, 0u, 0u};
                        if (r1 >= 0) z1 = *(const u32x4*)(Zb + (size_t)r1 * D + c8);
                        if (r2 >= 0) z2 = *(const u32x4*)(Zb + (size_t)r2 * D + c8);
                        const u32x4 gb = *(const u32x4*)(GBb + (size_t)r * D + c8);
                        const float* w0 = conv_w + c8; const float* w1 = conv_w + D + c8; const float* w2 = conv_w + 2 * D + c8;
                        u32x4 ov;
#pragma unroll
                        for (int e = 0; e < 4; ++e) {
                            const unsigned a0 = z0[e], a1 = z1[e], a2 = z2[e], ag = gb[e];
                            const float lo = bf2f((unsigned short)(ag & 0xffffu)) * (w2[2 * e] * bf2f((unsigned short)(a0 & 0xffffu)) + w1[2 * e] * bf2f((unsigned short)(a1 & 0xffffu)) + w0[2 * e] * bf2f((unsigned short)(a2 & 0xffffu)));
                            const float hi = bf2f((unsigned short)(ag >> 16)) * (w2[2 * e + 1] * bf2f((unsigned short)(a0 >> 16)) + w1[2 * e + 1] * bf2f((unsigned short)(a1 >> 16)) + w0[2 * e + 1] * bf2f((unsigned short)(a2 >> 16)));
                            ov[e] = cvtpk(lo, hi);
                        }
                        *(u32x4*)(Gb + (size_t)r * D + c8) = ov;
                    }
                } else {
                    { IDS(); pg8::Gemm g{Gb, (const bf16_t*)(wts + W_COUT), D, D, D, 0}; pg8::StaticOrder So; So.init(64, 4, G, bx);
                      pg8::EpiResid E{HB, r_hb, nullptr, r_ssq, nullptr, nullptr, r_mask};
                      pg8::gemm_phase<pg8::EpiResid>(lds, g, So, E, tid); }
                    if (!dry) { IDS(); for (int task = mw; task < 64; task += NGW) meta::task_res(task, Gb, D, 0, (const bf16_t*)(wts + W_COUT), D, D, nullptr, nullptr, hmeta, HB, ssqm, lane); }
                }
            } else {
                bf16_t* MIX = (bf16_t*)big;
                if (ph == first) {
                    IDS();
                    LAS float* rsl = (LAS float*)lds;
                    const float* gmix = norm_mix + (size_t)2 * D;
                    for (int ui = vcu; ui < NB * 128 + 1; ui += G) {
                        const bool mq = ui >= NB * 128; const int b = mq ? 0 : (ui >> 7), t0 = mq ? 0 : NMETA + (ui & 127) * 64;
                        __syncthreads();
                        if (tid < 79) { const int t = t0 - 15 + tid; float rs = 0.f;
                            if (t >= 0 && t < LSEQ) { const int row = rowof(b, t); float s = 0.f;
                                if (row < MR) { const f32x4* p = (const f32x4*)(ssq + (size_t)row * 16);
#pragma unroll
                                    for (int k = 0; k < 4; ++k) { const f32x4 a = p[k]; s += (a[0] + a[1]) + (a[2] + a[3]); } }
                                else { const f32x4* p = (const f32x4*)(ssqm + (size_t)(row - MR) * 64);
#pragma unroll
                                    for (int k = 0; k < 16; ++k) { const f32x4 a = p[k]; s += (a[0] + a[1]) + (a[2] + a[3]); } }
                                rs = 1.0f / sqrtf(s * (1.0f / D) + EPS); }
                            rsl[tid] = rs; }
                        __syncthreads();
                        const int c = 2 * tid, win = 2 << (c >> 8);
                        const f32x2 gg = *(const f32x2*)(gmix + c);
#define POOL_A(t) ({ const int _t = (t); f32x2 _a = (f32x2){0.f, 0.f}; if (_t >= 0) { const int _row = rowof(b, _t); const unsigned _hb = *(const unsigned*)(HB + (size_t)_row * D + c); \
                            const f32x2 _h = (f32x2){__builtin_bit_cast(float, _hb << 16), __builtin_bit_cast(float, _hb & 0xffff0000u)}; const float _rs = rsl[_t - (t0 - 15)]; _a = _h * _rs * gg; } _a; })
                        f32x2 Ssum = (f32x2){0.f, 0.f};
                        for (int jj = 1; jj < win; ++jj) Ssum += POOL_A(t0 - jj);
                        const int tend = mq ? NMETA : t0 + 64;
                        for (int t = t0; t < tend; ++t) {
                            const f32x2 at = POOL_A(t); Ssum += at;
                            const int cnt = win < t + 1 ? win : t + 1; const float ic = 1.0f / (float)cnt;
                            const f32x2 mx = Ssum * ic - at;
                            *(unsigned*)(MIX + (size_t)rowof(b, t) * D + c) = cvtpk(mx[0], mx[1]);
                            Ssum -= POOL_A(t - win + 1);
                        }
#undef POOL_A
                    }
                    __syncthreads();
                } else {
                    { IDS(); pg8::Gemm g{MIX, (const bf16_t*)(wts + W_POOL), D, 256, 256, 256}; pg8::StaticOrder So; So.init(64, 4, G, bx);
                      pg8::EpiResid E{HB, r_hb, nullptr, r_ssq, nullptr, pool_scale, r_mask};
                      pg8::gemm_phase<pg8::EpiResid>(lds, g, So, E, tid); }
                    if (!dry) { IDS(); for (int task = mw; task < 64; task += NGW) meta::task_res(task, MIX, D, 256, (const bf16_t*)(wts + W_POOL), 256, 256, nullptr, pool_scale, hmeta, HB, ssqm, lane); }
                }
            }
        }
        if (MK_N_LAUNCHES == 1 && dry) xcd_barrier(bar);
        }
        if (MK_N_LAUNCHES == 1 && ph + 1 < args.ph_hi) { xcd_barrier(bar); for (int xb = 0; xb < PROBE_XBAR; ++xb) xcd_barrier(bar); }
    }
#undef IDS
}

extern "C" void kernel_launch(void* const* d_in, const int* in_sizes, int n_in, void* d_out, int out_size, void* d_ws, size_t ws_size, hipStream_t stream) {
    static int grid = 0;
    if (grid == 0) {
        if (n_in != 19 || out_size != MR * D || ws_size < WS_END) { fprintf(stderr, "kernel_launch: unexpected shapes (n_in %d out %d ws %zu)\n", n_in, out_size, ws_size); grid = -1; return; }
        int dev = 0, cus = 0, per_cu = 0;
        if (hipGetDevice(&dev) != hipSuccess || hipDeviceGetAttribute(&cus, hipDeviceAttributeMultiprocessorCount, dev) != hipSuccess) { grid = -1; return; }
        if (hipFuncSetAttribute((const void*)mega_fwd, hipFuncAttributeMaxDynamicSharedMemorySize, LDS_BYTES) != hipSuccess) { fprintf(stderr, "kernel_launch: hipFuncSetAttribute failed\n"); grid = -1; return; }
        if (hipOccupancyMaxActiveBlocksPerMultiprocessor(&per_cu, (const void*)mega_fwd, NTHR, LDS_BYTES) != hipSuccess || per_cu < 1) { fprintf(stderr, "kernel_launch: occupancy query says %d blocks/CU\n", per_cu); }
        (void)hipGetLastError();
        grid = cus;
    }
    if (grid < 0) return;
    if (hipMemsetAsync((char*)d_ws + WS_CTL, 0, CTL_ZERO_BYTES, stream) != hipSuccess) { fprintf(stderr, "kernel_launch: memset failed\n"); return; }
    Args a{};
    for (int i = 0; i < 19; ++i) a.in[i] = (const float*)d_in[i];
    a.out = (float*)d_out; a.ws = (unsigned char*)d_ws;
    if (MK_N_LAUNCHES == 1) {
        a.ph_lo = 0; a.ph_hi = N_PHASES;
        hipLaunchKernelGGL(mega_fwd, dim3(grid), dim3(NTHR), LDS_BYTES, stream, a);
    } else {
        for (int ph = 0; ph < N_PHASES; ++ph) { a.ph_lo = ph; a.ph_hi = ph + 1; hipLaunchKernelGGL(mega_fwd, dim3(grid), dim3(NTHR), LDS_BYTES, stream, a); }
    }
}
```

```cpp
#include <hip/hip_runtime.h>
#include <cstdio>
#include <cstdint>

#ifndef MK_N_LAUNCHES
#define MK_N_LAUNCHES 1
#endif
#ifndef PROBE_MASK
#define PROBE_MASK 0u
#endif
#ifndef PROBE_XBAR
#define PROBE_XBAR 0
#endif

#define LAS __attribute__((address_space(3)))
#define GAS __attribute__((address_space(1)))
typedef unsigned short bf16_t;
typedef short bf16x8 __attribute__((ext_vector_type(8)));
typedef short s16x4 __attribute__((ext_vector_type(4)));
typedef float f32x2 __attribute__((ext_vector_type(2)));
typedef float f32x4 __attribute__((ext_vector_type(4)));
typedef float f32x16 __attribute__((ext_vector_type(16)));
typedef unsigned u32x2 __attribute__((ext_vector_type(2)));
typedef unsigned u32x4 __attribute__((ext_vector_type(4)));
typedef __bf16 bf16x2_t __attribute__((ext_vector_type(2)));

constexpr int D = 1024, NB = 2, S = 8192, NMETA = 16, LSEQ = S + NMETA;
constexpr int MR = NB * S;
constexpr int MT = MR + NMETA;
constexpr int MP = 65 * 256;
constexpr int NH = 16, NKV = 4, HD = 64, NQKV = 1536, FF = 2816;
constexpr float EPS = 1e-6f;
constexpr float LOG2E = 1.4426950408889634f;
constexpr float QSCALE = 0.125f * LOG2E;
constexpr int NWAVES = 8, NTHR = 512;

constexpr size_t MiB = 1u << 20;
constexpr size_t WS_CTL = 0, CTL_ZERO_BYTES = 1 * MiB;
constexpr size_t WS_HMETA = 1 * MiB;
constexpr size_t WS_SSQ = 2 * MiB;
constexpr size_t WS_SSQM = 3 * MiB + 512 * 1024;
constexpr size_t WS_TB = 4 * MiB;
constexpr size_t WS_W = 5 * MiB;
constexpr size_t W_QKV = 0, W_O = 3 * MiB, W_ATT_STRIDE = 5 * MiB;
constexpr size_t W_CIN = 10 * MiB, W_COUT = 16 * MiB, W_POOL = 18 * MiB;
constexpr size_t W_FFN = 19 * MiB, W_FFN_STRIDE = 33 * MiB / 2, W_GU = 0, W_DN = 11 * MiB;
constexpr size_t WS_HB = 90 * MiB;
constexpr size_t WS_BIG = 123 * MiB;
constexpr size_t BIG_QKV = 0, BIG_O = 49 * MiB;
constexpr size_t BIG_GB = 0, BIG_Z = 33 * MiB, BIG_G = 66 * MiB;
constexpr size_t WS_END = 256 * MiB;
static_assert(W_FFN + 4 * W_FFN_STRIDE <= 85 * MiB && WS_W + 85 * MiB <= WS_HB, "weights");
static_assert(WS_HB + (size_t)MP * D * 2 <= WS_BIG && WS_BIG + (size_t)MP * FF * 2 <= WS_END, "ws map");

constexpr int CW_BAR = 4096;

constexpr int RING_BYTES = 131072;
constexpr int LDSCTL_OFF = RING_BYTES, MISC_OFF = LDSCTL_OFF + 320;
constexpr int LDS_BYTES = 147456;

__device__ __forceinline__ unsigned cvtpk(float lo, float hi) { f32x2 v = {lo, hi}; bf16x2_t b = __builtin_convertvector(v, bf16x2_t); return __builtin_bit_cast(unsigned, b); }
__device__ __forceinline__ float bf2f(unsigned short u) { return __builtin_bit_cast(float, (unsigned)u << 16); }
__device__ __forceinline__ float wave_sum(float v) {
#pragma unroll
    for (int o = 1; o < 64; o <<= 1) v += __shfl_xor(v, o);
    return v;
}
__device__ __forceinline__ int rowof(int b, int t) { return t < NMETA ? MR + t : b * S + (t - NMETA); }
__device__ __forceinline__ int bucket_of(int dist) {
    if (dist < 16) return dist < 0 ? 0 : dist;
    int v = 16 + (int)(log2f((float)dist * 0.0625f) * (16.0f / 3.0f));
    return v > 31 ? 31 : v;
}
#define LDS_WAIT() asm volatile("s_waitcnt lgkmcnt(0)" ::: "memory")
#define VM_WAIT() asm volatile("s_waitcnt vmcnt(0)" ::: "memory")

namespace pg8 {
constexpr int BM = 256, BK = 64, HALF = 128, HTB = HALF * BK * 2, STAGE_BYTES = 8 * HTB, NXCD = 8, WGM = 8;
__host__ __device__ __forceinline__ int lds_byte(int r, int c) { const int st = (r >> 4) * 2 + (c >> 5), rr = r & 15, cc = c & 31, ob = rr * 64 + cc * 2; return st * 1024 + (ob ^ (((ob >> 9) & 1) << 5)); }
__host__ __device__ __forceinline__ void stage_rc(int b, int& R, int& C) { const int st = b / 1024, sb = b % 1024, swz = sb ^ (((sb >> 9) & 1) << 5); R = (st >> 1) * 16 + swz / 64; C = (st & 1) * 32 + (swz % 64) / 2; }
__host__ __device__ __forceinline__ int perm32(int rho) { const int n = rho >> 4, i = rho & 15; return 8 * (i >> 2) + 4 * n + (i & 3); }

struct Unit { int pm, pn; };
struct Gemm { const bf16_t* A; const bf16_t* Bt; int lda, ldb, K, a_pn_off; };

struct StaticOrder {
    int nM, nN, nwg, G, c;
    __device__ void init(int nM_, int nN_, int G_, int c_) { nM = nM_; nN = nN_; nwg = nM * nN; G = G_; c = c_; }
    __device__ bool next(int i, Unit& u) const {
        const long L = (long)i * G + c; if (L >= nwg) return false;
        int wgid = (int)L; { const int q = nwg / NXCD, r = nwg % NXCD, xcd = wgid % NXCD, off = wgid / NXCD; wgid = (xcd < r ? xcd * (q + 1) : r * (q + 1) + (xcd - r) * q) + off; }
        const int nig = WGM * nN, gid = wgid / nig, fm = gid * WGM, gsz = (nM - fm) < WGM ? (nM - fm) : WGM;
        u.pm = fm + ((wgid % nig) % gsz); u.pn = (wgid % nig) / gsz; return true;
    }
};

__device__ __forceinline__ float rstd_of(const float* ssq, int row) {
    const f32x4* p = (const f32x4*)(ssq + (size_t)row * 16);
    const f32x4 a = p[0], b = p[1], c = p[2], d = p[3];
    const float s = ((a[0] + a[1]) + (a[2] + a[3])) + ((b[0] + b[1]) + (b[2] + b[3])) + ((c[0] + c[1]) + (c[2] + c[3])) + ((d[0] + d[1]) + (d[2] + d[3]));
    return __builtin_amdgcn_rsqf(s * (1.0f / D) + EPS);
}

struct EpiQKV {
    static constexpr bool PERM = true;
    bf16_t* O; const float* bias; const float* ssq;
    __device__ __forceinline__ void operator()(const f32x4 (&acc)[2][2][4][2], const Unit& u, int wr, int wc, int fr, int fq) const {
        const int row0 = u.pm * BM + wr * 64 + fr, col0 = u.pn * BM + wc * 32 + 8 * fq;
        const float sc = u.pn < 4 ? QSCALE : 1.0f;
        f32x4 bv[2][2];
#pragma unroll
        for (int bj = 0; bj < 2; ++bj)
#pragma unroll
            for (int n = 0; n < 2; ++n) bv[bj][n] = *(const f32x4*)(bias + col0 + bj * HALF + 4 * n);
#pragma unroll
        for (int ai = 0; ai < 2; ++ai)
#pragma unroll
            for (int m = 0; m < 4; ++m) {
                const int row = row0 + ai * HALF + m * 16; const float rs = rstd_of(ssq, row);
                bf16_t* rowp = O + (size_t)row * NQKV + col0;
#pragma unroll
                for (int bj = 0; bj < 2; ++bj) {
                    const f32x4 v0 = (acc[ai][bj][m][0] * rs + bv[bj][0]) * sc, v1 = (acc[ai][bj][m][1] * rs + bv[bj][1]) * sc;
                    u32x4 w; w.x = cvtpk(v0[0], v0[1]); w.y = cvtpk(v0[2], v0[3]); w.z = cvtpk(v1[0], v1[1]); w.w = cvtpk(v1[2], v1[3]);
                    *(u32x4*)(rowp + bj * HALF) = w;
                }
            }
    }
};
__device__ __forceinline__ float silu_mul(float g, float u) { return g * __builtin_amdgcn_rcpf(1.0f + __builtin_amdgcn_exp2f(-g * LOG2E)) * u; }
struct EpiSwiGLU {
    static constexpr bool PERM = true;
    bf16_t* O; const float* ssq;
    __device__ __forceinline__ void operator()(const f32x4 (&acc)[2][2][4][2], const Unit& u, int wr, int wc, int fr, int fq) const {
        const int row0 = u.pm * BM + wr * 64 + fr, col0 = u.pn * HALF + wc * 32 + 8 * fq;
#pragma unroll
        for (int ai = 0; ai < 2; ++ai)
#pragma unroll
            for (int m = 0; m < 4; ++m) {
                const int row = row0 + ai * HALF + m * 16; const float rs = rstd_of(ssq, row);
                const f32x4 g0 = acc[ai][0][m][0] * rs, g1 = acc[ai][0][m][1] * rs, u0 = acc[ai][1][m][0] * rs, u1 = acc[ai][1][m][1] * rs;
                u32x4 w; w.x = cvtpk(silu_mul(g0[0], u0[0]), silu_mul(g0[1], u0[1])); w.y = cvtpk(silu_mul(g0[2], u0[2]), silu_mul(g0[3], u0[3]));
                w.z = cvtpk(silu_mul(g1[0], u1[0]), silu_mul(g1[1], u1[1])); w.w = cvtpk(silu_mul(g1[2], u1[2]), silu_mul(g1[3], u1[3]));
                *(u32x4*)(O + (size_t)row * FF + col0) = w;
            }
    }
};
struct EpiConvIn {
    static constexpr bool PERM = true;
    bf16_t* GB; bf16_t* Z; const float* ssq;
    __device__ __forceinline__ void operator()(const f32x4 (&acc)[2][2][4][2], const Unit& u, int wr, int wc, int fr, int fq) const {
        const int row0 = u.pm * BM + wr * 64 + fr;
        if (u.pn < 4) {
            const int col0 = u.pn * BM + wc * 32 + 8 * fq;
#pragma unroll
            for (int ai = 0; ai < 2; ++ai)
#pragma unroll
                for (int m = 0; m < 4; ++m) {
                    const int row = row0 + ai * HALF + m * 16; const float rs = rstd_of(ssq, row);
                    bf16_t* rowp = GB + (size_t)row * D + col0;
#pragma unroll
                    for (int bj = 0; bj < 2; ++bj) {
                        const f32x4 v0 = acc[ai][bj][m][0] * rs, v1 = acc[ai][bj][m][1] * rs;
                        u32x4 w; w.x = cvtpk(v0[0], v0[1]); w.y = cvtpk(v0[2], v0[3]); w.z = cvtpk(v1[0], v1[1]); w.w = cvtpk(v1[2], v1[3]);
                        *(u32x4*)(rowp + bj * HALF) = w;
                    }
                }
        } else {
            const int col0 = (u.pn - 4) * HALF + wc * 32 + 8 * fq;
#pragma unroll
            for (int ai = 0; ai < 2; ++ai)
#pragma unroll
                for (int m = 0; m < 4; ++m) {
                    const int row = row0 + ai * HALF + m * 16; const float rs = rstd_of(ssq, row); const float r2 = rs * rs;
                    const f32x4 z0 = acc[ai][0][m][0] * acc[ai][1][m][0] * r2, z1 = acc[ai][0][m][1] * acc[ai][1][m][1] * r2;
                    u32x4 w; w.x = cvtpk(z0[0], z0[1]); w.y = cvtpk(z0[2], z0[3]); w.z = cvtpk(z1[0], z1[1]); w.w = cvtpk(z1[2], z1[3]);
                    *(u32x4*)(Z + (size_t)row * D + col0) = w;
                }
        }
    }
};
struct EpiResid {
    static constexpr bool PERM = false;
    const bf16_t* HBi; bf16_t* HBo; float* fout; float* ssq; const float* bias; const float* cscale; int rmask;
    __device__ __forceinline__ void operator()(const f32x4 (&acc)[2][2][4][2], const Unit& u, int wr, int wc, int fr, int fq) const {
        const int col0 = u.pn * BM + wc * 32 + 4 * fq;
        f32x4 bv[2][2], cs[2][2];
#pragma unroll
        for (int bj = 0; bj < 2; ++bj)
#pragma unroll
            for (int n = 0; n < 2; ++n) {
                bv[bj][n] = bias ? *(const f32x4*)(bias + col0 + bj * HALF + n * 16) : (f32x4){0.f, 0.f, 0.f, 0.f};
                cs[bj][n] = cscale ? *(const f32x4*)(cscale + col0 + bj * HALF + n * 16) : (f32x4){1.f, 1.f, 1.f, 1.f};
            }
        const size_t off0 = (size_t)(u.pm * BM + wr * 64 + fr) * D + col0;
        u32x2 cur[2][2], nxt[2][2];
#pragma unroll
        for (int bj = 0; bj < 2; ++bj)
#pragma unroll
            for (int n = 0; n < 2; ++n) cur[bj][n] = *(const u32x2*)(HBi + off0 + bj * HALF + n * 16);
#pragma unroll
        for (int gi = 0; gi < 8; ++gi) {
            const int ai = gi >> 2, m = gi & 3;
            if (gi < 7) { const size_t offn = off0 + (size_t)(((gi + 1) >> 2) * HALF + ((gi + 1) & 3) * 16) * D;
#pragma unroll
                for (int bj = 0; bj < 2; ++bj)
#pragma unroll
                    for (int n = 0; n < 2; ++n) nxt[bj][n] = *(const u32x2*)(HBi + offn + bj * HALF + n * 16); }
            const int srow = (u.pm * BM + ai * HALF + wr * 64 + m * 16 + fr) & rmask; const size_t soff = (size_t)srow * D + col0;
            float q = 0.f;
#pragma unroll
            for (int bj = 0; bj < 2; ++bj)
#pragma unroll
                for (int n = 0; n < 2; ++n) {
                    const u32x2 hb = cur[bj][n];
                    const f32x4 h4 = (f32x4){__builtin_bit_cast(float, hb.x << 16), __builtin_bit_cast(float, hb.x & 0xffff0000u), __builtin_bit_cast(float, hb.y << 16), __builtin_bit_cast(float, hb.y & 0xffff0000u)};
                    const f32x4 v = h4 + (acc[ai][bj][m][n] + bv[bj][n]) * cs[bj][n];
                    if (fout) *(f32x4*)(fout + soff + bj * HALF + n * 16) = v;
                    u32x2 w; w.x = cvtpk(v[0], v[1]); w.y = cvtpk(v[2], v[3]);
                    *(u32x2*)(HBo + soff + bj * HALF + n * 16) = w;
                    q += (v[0] * v[0] + v[1] * v[1]) + (v[2] * v[2] + v[3] * v[3]);
                }
            q += __shfl_xor(q, 16); q += __shfl_xor(q, 32);
            if (fq == 0) ssq[(size_t)srow * 16 + u.pn * 4 + wc] = q;
#pragma unroll
            for (int bj = 0; bj < 2; ++bj)
#pragma unroll
                for (int n = 0; n < 2; ++n) cur[bj][n] = nxt[bj][n];
        }
    }
};

template <class Epi>
__device__ __forceinline__ void gemm_phase(LAS unsigned char* lds, const Gemm g, const StaticOrder& S, const Epi& E, const int tid) {
    const int wid = __builtin_amdgcn_readfirstlane(tid >> 6), lane = tid & 63, wr = wid >> 2, wc = wid & 3, fr = lane & 15, fq = lane >> 4;
    const int K = g.K, nt = K / BK;
    unsigned voffA[2], voffB[2];
#pragma unroll
    for (int i = 0; i < 2; ++i) { int R, C; stage_rc(tid * 16 + i * 8192, R, C); const int Rb = Epi::PERM ? ((R & ~31) + perm32(R & 31)) : R;
        voffA[i] = (unsigned)(R * g.lda + C) * 2u; voffB[i] = (unsigned)(Rb * g.ldb + C) * 2u; }
    const size_t kstep = (size_t)(BK * 2);
    const size_t hstepA = (size_t)HALF * g.lda * 2, hstepB = (size_t)HALF * g.ldb * 2;
    const size_t tstepA = 2 * hstepA, tstepB = 2 * hstepB;
    const size_t pnoffA = (size_t)g.a_pn_off * 2;
    const unsigned ldsw = (unsigned)wid * 1024u;
    const int aoff = lds_byte(wr * 64 + fr, fq * 8), boff = lds_byte(wc * 32 + fr, fq * 8);
#define PG8_SA(b, h) (((b) * 2 + (h)) * HTB)
#define PG8_SB(b, h) ((4 + (b) * 2 + (h)) * HTB)
#define PG8_STAGE(bufoff, gbase, voff) do { _Pragma("unroll") for (int _i = 0; _i < 2; ++_i) \
        __builtin_amdgcn_global_load_lds((const unsigned*)((const char*)(gbase) + (voff)[_i]), (LAS unsigned*)(lds + (bufoff) + ldsw + _i * 8192), 16, 0, 0); } while (0)
#define PG8_LDA(dst, b, h) do { _Pragma("unroll") for (int m = 0; m < 4; ++m) _Pragma("unroll") for (int k = 0; k < 2; ++k) dst[m][k] = *(const LAS bf16x8*)(lds + PG8_SA(b, h) + aoff + m * 2048 + k * 1024); } while (0)
#define PG8_LDB(dst, b, h) do { _Pragma("unroll") for (int n = 0; n < 2; ++n) _Pragma("unroll") for (int k = 0; k < 2; ++k) dst[n][k] = *(const LAS bf16x8*)(lds + PG8_SB(b, h) + boff + n * 2048 + k * 1024); } while (0)
#define PG8_MMA(ai, bj, At, Bt) do { __builtin_amdgcn_s_setprio(1); _Pragma("unroll") for (int m = 0; m < 4; ++m) _Pragma("unroll") for (int n = 0; n < 2; ++n) _Pragma("unroll") for (int k = 0; k < 2; ++k) \
        acc[ai][bj][m][n] = __builtin_amdgcn_mfma_f32_16x16x32_bf16(Bt[n][k], At[m][k], acc[ai][bj][m][n], 0, 0, 0); __builtin_amdgcn_s_setprio(0); } while (0)
#define PG8_WAIT_V(n) asm volatile("s_waitcnt vmcnt(" #n ")" ::: "memory")
#define PG8_WAIT_L(n) asm volatile("s_waitcnt lgkmcnt(" #n ")" ::: "memory")
#define PG8_BAR __builtin_amdgcn_s_barrier()
#define PG8_SCHED __builtin_amdgcn_sched_barrier(0)
    Unit cur, nxt; int ui = 0;
    if (!S.next(0, cur)) return;
    f32x4 acc[2][2][4][2];
#pragma unroll
    for (int a = 0; a < 2; ++a)
#pragma unroll
        for (int b = 0; b < 2; ++b)
#pragma unroll
            for (int m = 0; m < 4; ++m)
#pragma unroll
                for (int n = 0; n < 2; ++n) acc[a][b][m][n] = (f32x4){0.f, 0.f, 0.f, 0.f};
    bf16x8 At[4][2], B0[2][2], B1[2][2];
    const char* cA = (const char*)g.A + (size_t)cur.pm * tstepA + (size_t)cur.pn * pnoffA; const char* cB = (const char*)g.Bt + (size_t)cur.pn * tstepB;
    PG8_STAGE(PG8_SB(0, 0), cB, voffB); PG8_STAGE(PG8_SB(0, 1), cB + hstepB, voffB); PG8_STAGE(PG8_SA(0, 0), cA, voffA); PG8_STAGE(PG8_SA(0, 1), cA + hstepA, voffA);
    if (wr == 1) PG8_BAR;
    PG8_WAIT_V(2); PG8_BAR;
    PG8_STAGE(PG8_SB(1, 0), cB + kstep, voffB); PG8_STAGE(PG8_SA(1, 0), cA + kstep, voffA); PG8_STAGE(PG8_SB(1, 1), cB + hstepB + kstep, voffB);
    PG8_WAIT_V(6); PG8_BAR;
    for (;;) {
        const bool has_next = S.next(ui + 1, nxt);
        const char* nA = has_next ? (const char*)g.A + (size_t)nxt.pm * tstepA + (size_t)nxt.pn * pnoffA : cA; const char* nB = has_next ? (const char*)g.Bt + (size_t)nxt.pn * tstepB : cB;
        for (int t = 0; t < nt; t += 2) {
            const bool last = (t == nt - 2);
            const char* a1 = cA + (size_t)(t + 1) * kstep;
            const char* a2 = last ? nA : cA + (size_t)(t + 2) * kstep; const char* b2 = last ? nB : cB + (size_t)(t + 2) * kstep;
            const char* a3 = a2 + kstep; const char* b3 = b2 + kstep;
            PG8_LDB(B0, 0, 0); PG8_LDB(B1, 0, 1); PG8_SCHED; PG8_LDA(At, 0, 0); PG8_STAGE(PG8_SA(1, 1), a1 + hstepA, voffA);
            PG8_WAIT_V(8); PG8_WAIT_L(0); PG8_BAR; PG8_MMA(0, 0, At, B0); PG8_MMA(0, 1, At, B1); PG8_BAR; PG8_SCHED;
            PG8_LDA(At, 0, 1); PG8_STAGE(PG8_SB(0, 0), b2, voffB); PG8_STAGE(PG8_SB(0, 1), b2 + hstepB, voffB); PG8_STAGE(PG8_SA(0, 0), a2, voffA);
            PG8_WAIT_V(8); PG8_WAIT_L(0); PG8_BAR; PG8_MMA(1, 0, At, B0); PG8_MMA(1, 1, At, B1); PG8_BAR; PG8_SCHED;
            PG8_LDB(B0, 1, 0); PG8_LDB(B1, 1, 1); PG8_SCHED; PG8_LDA(At, 1, 0); PG8_STAGE(PG8_SA(0, 1), a2 + hstepA, voffA);
            PG8_WAIT_V(8); PG8_WAIT_L(0); PG8_BAR; PG8_MMA(0, 0, At, B0); PG8_MMA(0, 1, At, B1); PG8_BAR; PG8_SCHED;
            PG8_LDA(At, 1, 1); PG8_STAGE(PG8_SB(1, 0), b3, voffB); PG8_STAGE(PG8_SB(1, 1), b3 + hstepB, voffB); PG8_STAGE(PG8_SA(1, 0), a3, voffA);
            PG8_WAIT_V(8); PG8_WAIT_L(0); PG8_BAR; PG8_MMA(1, 0, At, B0); PG8_MMA(1, 1, At, B1); PG8_BAR; PG8_SCHED;
        }
        if (wr == 0) PG8_BAR;
        E(acc, cur, wr, wc, fr, fq);
        if (!has_next) break;
#pragma unroll
        for (int a = 0; a < 2; ++a)
#pragma unroll
            for (int b = 0; b < 2; ++b)
#pragma unroll
                for (int m = 0; m < 4; ++m)
#pragma unroll
                    for (int n = 0; n < 2; ++n) acc[a][b][m][n] = (f32x4){0.f, 0.f, 0.f, 0.f};
        cur = nxt; cA = nA; cB = nB; ++ui;
        if (wr == 1) PG8_BAR;
    }
    PG8_WAIT_V(0);
    PG8_BAR;
#undef PG8_SA
#undef PG8_SB
#undef PG8_STAGE
#undef PG8_LDA
#undef PG8_LDB
#undef PG8_MMA
#undef PG8_WAIT_V
#undef PG8_WAIT_L
#undef PG8_BAR
#undef PG8_SCHED
}
}

namespace att {
constexpr int R = 288;
constexpr int K_OFF = 0, K_BYTES = 8 * R * 16, V_OFF = K_BYTES, V_BYTES = 2 * R * 64, TB_OFF = V_OFF + V_BYTES, TOTAL = TB_OFF + 4 * 256 * 4;
static_assert(TOTAL <= RING_BYTES, "attention LDS");
__device__ __forceinline__ s16x4 vtr(const LAS unsigned char* p) { return __builtin_amdgcn_ds_read_tr16_b64_v4i16((LAS s16x4*)p); }

template <int NT, bool META>
__device__ __forceinline__ void group(const LAS unsigned char* lds, const bf16_t* qkv, bf16_t* o, float sink2, int b, int kvh, int nblk, int g, int qs, int lane) {
    const int q = lane & 31, hi = lane >> 5, hq = 4 * kvh + g;
    int row; if (META) row = MR + (q < NMETA ? q : NMETA - 1); else row = b * S + nblk * 128 + 32 * qs + q;
    bf16x8 qf[4];
#pragma unroll
    for (int ds = 0; ds < 4; ++ds) qf[ds] = *(const bf16x8*)(qkv + (size_t)row * NQKV + hq * 64 + 16 * ds + 8 * hi);
    f32x16 sc[NT];
#pragma unroll
    for (int ti = 0; ti < NT; ++ti) {
        const int rb = ti == 0 ? 0 : 32 * (qs + ti);
        f32x16 a = {};
#pragma unroll
        for (int ds = 0; ds < 4; ++ds) { const bf16x8 kf = *(const LAS bf16x8*)(lds + K_OFF + (2 * ds + hi) * (R * 16) + (rb + q) * 16); a = __builtin_amdgcn_mfma_f32_32x32x16_bf16(kf, qf[ds], a, 0, 0, 0); }
        sc[ti] = a;
    }
    const LAS float* tb = (const LAS float*)(lds + TB_OFF) + g * 256;
    float mx = sink2;
    int base[16];
#pragma unroll
    for (int r = 0; r < 16; ++r) base[r] = (r & 3) + 8 * (r >> 2) + 4 * hi - q;
#pragma unroll
    for (int ti = 0; ti < NT; ++ti) {
        if (ti == 0) {
#pragma unroll
            for (int r = 0; r < 16; ++r) {
                float v = -1e30f;
                if (r < 8) {
                    const int kk = (r & 3) + 8 * (r >> 2) + 4 * hi;
                    if (META) { v = kk <= q ? sc[0][r] + tb[(q - kk) & 255] : -1e30f; }
                    else { int dist = NMETA + nblk * 128 + 32 * qs + q - kk; dist = dist > 255 ? 255 : dist; v = sc[0][r] + tb[dist]; }
                }
                sc[0][r] = v; mx = fmaxf(mx, v);
            }
        } else {
            const bool tile_ok = nblk > 0 || qs + ti - 1 >= 4;
#pragma unroll
            for (int r = 0; r < 16; ++r) {
                const float bias = tb[128 - 32 * (ti - 1) - base[r]];
                bool valid = tile_ok;
                if (ti == 1) valid = valid && base[r] >= 1;
                if (ti == 5) valid = valid && base[r] <= 0;
                const float v = valid ? sc[ti][r] + bias : -1e30f; sc[ti][r] = v; mx = fmaxf(mx, v);
            }
        }
    }
    mx = fmaxf(mx, __shfl_xor(mx, 32));
    float ls = 0.f;
#pragma unroll
    for (int ti = 0; ti < NT; ++ti)
#pragma unroll
        for (int r = 0; r < 16; ++r) { const float p = __builtin_amdgcn_exp2f(sc[ti][r] - mx); sc[ti][r] = p; ls += p; }
    ls += __shfl_xor(ls, 32); ls += __builtin_amdgcn_exp2f(sink2 - mx);
    f32x16 oT[2]; oT[0] = f32x16{}; oT[1] = f32x16{};
#pragma unroll
    for (int ti = 0; ti < NT; ++ti) {
        const int rb = ti == 0 ? 0 : 32 * (qs + ti);
#pragma unroll
        for (int s = 0; s < 2; ++s) {
            u32x4 pw; pw.x = cvtpk(sc[ti][8 * s + 0], sc[ti][8 * s + 1]); pw.y = cvtpk(sc[ti][8 * s + 2], sc[ti][8 * s + 3]); pw.z = cvtpk(sc[ti][8 * s + 4], sc[ti][8 * s + 5]); pw.w = cvtpk(sc[ti][8 * s + 6], sc[ti][8 * s + 7]);
            const bf16x8 pf = __builtin_bit_cast(bf16x8, pw);
#pragma unroll
            for (int dt = 0; dt < 2; ++dt) {
                const LAS unsigned char* vp = lds + V_OFF + dt * (R * 64) + (rb + 16 * s + 4 * hi + ((lane & 15) >> 2)) * 64 + ((lane >> 4) & 1) * 32 + (lane & 3) * 8;
                const s16x4 lo = vtr(vp), h4 = vtr(vp + 512);
                const bf16x8 vf = (bf16x8){lo[0], lo[1], lo[2], lo[3], h4[0], h4[1], h4[2], h4[3]};
                oT[dt] = __builtin_amdgcn_mfma_f32_32x32x16_bf16(vf, pf, oT[dt], 0, 0, 0);
            }
        }
    }
    const float inv = 1.0f / ls;
    if (!META || q < NMETA) {
#pragma unroll
        for (int dt = 0; dt < 2; ++dt)
#pragma unroll
            for (int rg = 0; rg < 4; ++rg) {
                u32x2 w; w.x = cvtpk(oT[dt][4 * rg + 0] * inv, oT[dt][4 * rg + 1] * inv); w.y = cvtpk(oT[dt][4 * rg + 2] * inv, oT[dt][4 * rg + 3] * inv);
                *(u32x2*)(o + (size_t)row * D + hq * 64 + 32 * dt + 8 * rg + 4 * hi) = w;
            }
    }
}

__device__ __forceinline__ void unit(LAS unsigned char* lds, const bf16_t* qkv, bf16_t* o, const float* TBg, const float* sinks, int b, int kvh, int nblk, int tid) {
    asm volatile("" : "+v"(tid));
    const int lane = tid & 63, wid = __builtin_amdgcn_readfirstlane(tid >> 6);
#pragma unroll
    for (int i = 0; i < 9; ++i) {
        const int task = tid + NTHR * i, isv = task >= 8 * R ? 1 : 0, rem = task - isv * 8 * R, row = rem >> 3, ch = rem & 7;
        int grow = -1;
        if (row < 32) { if (row < NMETA) grow = MR + row; }
        else { const int jk = row - 32; if (nblk < 64 && (nblk > 0 || jk >= 128)) grow = b * S + (nblk - 1) * 128 + jk; }
        u32x4 v = (u32x4){0u, 0u, 0u, 0u};
        if (grow >= 0) v = *(const u32x4*)(qkv + (size_t)grow * NQKV + 1024 + isv * 256 + kvh * 64 + ch * 8);
        const int dst = isv ? V_OFF + (ch >> 2) * (R * 64) + row * 64 + (ch & 3) * 16 : K_OFF + ch * (R * 16) + row * 16;
        *(LAS u32x4*)(lds + dst) = v;
    }
    { LAS float* tb = (LAS float*)(lds + TB_OFF); tb[tid] = TBg[(size_t)(4 * kvh) * 256 + tid]; tb[tid + 512] = TBg[(size_t)(4 * kvh) * 256 + tid + 512]; }
    __syncthreads();
    const int g = wid >> 1;
    const float sink2 = sinks[4 * kvh + g] * LOG2E;
    if (nblk < 64) {
#pragma unroll 1
        for (int i = 0; i < 2; ++i) group<6, false>(lds, qkv, o, sink2, b, kvh, nblk, g, 2 * (wid & 1) + i, lane);
    } else if ((wid & 1) == 0) {
        group<1, true>(lds, qkv, o, sink2, b, kvh, nblk, g, 0, lane);
    }
    __syncthreads();
}
}

namespace meta {
__device__ __forceinline__ bf16_t tobf(float v) { return (bf16_t)(cvtpk(v, 0.f) & 0xffffu); }
__device__ __forceinline__ void rstd4(const float* ssqm, int lane, float (&rs)[4]) {
    const f32x4* p = (const f32x4*)(ssqm + (lane & 15) * 64 + (lane >> 4) * 16);
    const f32x4 a = p[0], b = p[1], c = p[2], d = p[3];
    float s = ((a[0] + a[1]) + (a[2] + a[3])) + ((b[0] + b[1]) + (b[2] + b[3])) + ((c[0] + c[1]) + (c[2] + c[3])) + ((d[0] + d[1]) + (d[2] + d[3]));
    s += __shfl_xor(s, 16); s += __shfl_xor(s, 32);
    const float r = __builtin_amdgcn_rsqf(s * (1.0f / D) + EPS);
#pragma unroll
    for (int reg = 0; reg < 4; ++reg) rs[reg] = __shfl(r, 4 * (lane >> 4) + reg);
}
template <int NBF>
__device__ __forceinline__ void mma16(const bf16_t* A, int lda, const bf16_t* B0, const bf16_t* B1, int ldb, int K, f32x4& c0, f32x4& c1, int lane) {
    const int r = lane & 15, kq = lane >> 4;
    const bf16_t* ap = A + (size_t)r * lda + 8 * kq; const bf16_t* bp0 = B0 + (size_t)r * ldb + 8 * kq; const bf16_t* bp1 = B1 + (size_t)r * ldb + 8 * kq;
    for (int k = 0; k < K; k += 256) {
        bf16x8 a[8], b0[8], b1[8];
#pragma unroll
        for (int u = 0; u < 8; ++u) { a[u] = *(const bf16x8*)(ap + k + 32 * u); b0[u] = *(const bf16x8*)(bp0 + k + 32 * u); if (NBF == 2) b1[u] = *(const bf16x8*)(bp1 + k + 32 * u); }
#pragma unroll
        for (int u = 0; u < 8; ++u) { c0 = __builtin_amdgcn_mfma_f32_16x16x32_bf16(a[u], b0[u], c0, 0, 0, 0); if (NBF == 2) c1 = __builtin_amdgcn_mfma_f32_16x16x32_bf16(a[u], b1[u], c1, 0, 0, 0); }
    }
}
__device__ __forceinline__ void task_qkv(int task, const bf16_t* HB, const bf16_t* Wt, const float* bias, const float* ssqm, bf16_t* qkv, int lane) {
    const int n0 = 16 * task; f32x4 c0 = {0.f, 0.f, 0.f, 0.f}, c1 = c0;
    mma16<1>(HB + (size_t)MR * D, D, Wt + (size_t)n0 * D, Wt, D, D, c0, c1, lane);
    float rs[4]; rstd4(ssqm, lane, rs);
    const int n = n0 + (lane & 15); const float bv = bias[n], sc = n0 < 1024 ? QSCALE : 1.0f;
#pragma unroll
    for (int reg = 0; reg < 4; ++reg) { const int row = 4 * (lane >> 4) + reg; qkv[(size_t)(MR + row) * NQKV + n] = tobf((c0[reg] * rs[reg] + bv) * sc); }
}
__device__ __forceinline__ void task_gu(int task, const bf16_t* HB, const bf16_t* Wgu, const float* ssqm, bf16_t* act, int lane) {
    const int c = 16 * task; f32x4 c0 = {0.f, 0.f, 0.f, 0.f}, c1 = c0;
    const bf16_t* B0 = Wgu + (size_t)(256 * (c >> 7) + (c & 127)) * D;
    mma16<2>(HB + (size_t)MR * D, D, B0, B0 + (size_t)128 * D, D, D, c0, c1, lane);
    float rs[4]; rstd4(ssqm, lane, rs);
#pragma unroll
    for (int reg = 0; reg < 4; ++reg) { const int row = 4 * (lane >> 4) + reg; act[(size_t)(MR + row) * FF + c + (lane & 15)] = tobf(pg8::silu_mul(c0[reg] * rs[reg], c1[reg] * rs[reg])); }
}
__device__ __forceinline__ void task_cin(int task, const bf16_t* HB, const bf16_t* Wcin, const float* ssqm, bf16_t* GB, bf16_t* Z, int lane) {
    f32x4 c0 = {0.f, 0.f, 0.f, 0.f}, c1 = c0; float rs[4];
    if (task < 64) {
        const int n0 = 16 * task;
        mma16<1>(HB + (size_t)MR * D, D, Wcin + (size_t)n0 * D, Wcin, D, D, c0, c1, lane);
        rstd4(ssqm, lane, rs);
#pragma unroll
        for (int reg = 0; reg < 4; ++reg) { const int row = 4 * (lane >> 4) + reg; GB[(size_t)(MR + row) * D + n0 + (lane & 15)] = tobf(c0[reg] * rs[reg]); }
    } else {
        const int c = 16 * (task - 64);
        const bf16_t* B0 = Wcin + (size_t)(1024 + 256 * (c >> 7) + (c & 127)) * D;
        mma16<2>(HB + (size_t)MR * D, D, B0, B0 + (size_t)128 * D, D, D, c0, c1, lane);
        rstd4(ssqm, lane, rs);
#pragma unroll
        for (int reg = 0; reg < 4; ++reg) { const int row = 4 * (lane >> 4) + reg; Z[(size_t)(MR + row) * D + c + (lane & 15)] = tobf(c0[reg] * c1[reg] * rs[reg] * rs[reg]); }
    }
}
__device__ __forceinline__ void task_res(int task, const bf16_t* A, int lda, int a_pn_off, const bf16_t* Wt, int ldb, int K, const float* bias, const float* cscale, float* hmeta, bf16_t* HB, float* ssqm, int lane) {
    const int n0 = 16 * task; f32x4 c0 = {0.f, 0.f, 0.f, 0.f}, c1 = c0;
    mma16<1>(A + (size_t)MR * lda + (size_t)(n0 >> 8) * a_pn_off, lda, Wt + (size_t)n0 * ldb, Wt, ldb, K, c0, c1, lane);
    const int n = n0 + (lane & 15); const float bv = bias ? bias[n] : 0.f, cs = cscale ? cscale[n] : 1.0f;
#pragma unroll
    for (int reg = 0; reg < 4; ++reg) {
        const int row = 4 * (lane >> 4) + reg;
        const float v = hmeta[(size_t)row * D + n] + (c0[reg] + bv) * cs;
        hmeta[(size_t)row * D + n] = v; HB[(size_t)(MR + row) * D + n] = tobf(v);
        float q = v * v; q += __shfl_xor(q, 1); q += __shfl_xor(q, 2); q += __shfl_xor(q, 4); q += __shfl_xor(q, 8);
        if ((lane & 15) == 0) ssqm[row * 64 + task] = q;
    }
}
}

#define XB_TMO      128
#define XB_XCNT(j)  (256  + 64 * (j))
#define XB_XSUB(j)  (1280 + 64 * (j))
#define XB_XGEN(j)  (2304 + 64 * (j))
#define XB_TOP      3328
#define XB_TOPGEN   3392
#define XCD_BAR_WORDS 3456
#define XB_SPIN_CAP (1u << 18)
__device__ __forceinline__ unsigned xb_ld(unsigned* p)              { return __hip_atomic_load(p, __ATOMIC_RELAXED, __HIP_MEMORY_SCOPE_AGENT); }
__device__ __forceinline__ unsigned xb_add(unsigned* p, unsigned v) { return __hip_atomic_fetch_add(p, v, __ATOMIC_RELAXED, __HIP_MEMORY_SCOPE_AGENT); }
__device__ __forceinline__ unsigned xb_xcc_id() { return (unsigned)__builtin_amdgcn_s_getreg((3 << 11) | 20) & 0xFu; }
#define XB_SPIN(cond, bar) do { unsigned _sp = 0; while (cond) { __builtin_amdgcn_s_sleep(1); \
    if ((++_sp & 255u) == 0u) { if (xb_ld(&(bar)[XB_TMO])) break; if (_sp > XB_SPIN_CAP) { atomicAdd(&(bar)[XB_TMO], 1u); break; } } } } while (0)
struct XcdBarrier { unsigned* bar; unsigned x; volatile LAS unsigned* st; };
__device__ __forceinline__ XcdBarrier xcd_barrier_post(unsigned* bar, volatile LAS unsigned* st) {
    XcdBarrier b; b.bar = bar; b.x = xb_xcc_id(); b.st = st;
    if (threadIdx.x == 0) (void)xb_add(&bar[XB_XCNT(b.x)], 1u);
    return b;
}
__device__ __forceinline__ void xcd_barrier_complete(unsigned* bar, unsigned x, unsigned& nloc, unsigned& nx) {
    const unsigned G = gridDim.x * gridDim.y * gridDim.z;
    unsigned sum, cnt, mine, sp = 0u;
    for (;;) {
        sum = 0u; cnt = 0u; mine = 0u;
#pragma unroll
        for (unsigned j = 0; j < 16; ++j) { const unsigned c = xb_ld(&bar[XB_XCNT(j)]); sum += c; cnt += (c > 0u) ? 1u : 0u; mine = (j == x) ? c : mine; }
        if (sum == G) break;
        __builtin_amdgcn_s_sleep(1);
        if ((++sp & 255u) == 0u) { if (xb_ld(&bar[XB_TMO])) break; if (sp > XB_SPIN_CAP) { atomicAdd(&bar[XB_TMO], 1u); break; } }
    }
    nloc = mine > 0u ? mine : 1u; nx = cnt > 0u ? cnt : 1u;
}
__device__ __forceinline__ void xcd_barrier(const XcdBarrier& b) {
    asm volatile("s_waitcnt vmcnt(0)" ::: "memory");
    __syncthreads();
    if (threadIdx.x == 0) {
        unsigned* bar = b.bar;
        __builtin_amdgcn_s_waitcnt(0);
        unsigned nloc = b.st[0], nx = b.st[1];
        if (nloc == 0u) { xcd_barrier_complete(bar, b.x, nloc, nx); b.st[0] = nloc; b.st[1] = nx; }
        const unsigned old = xb_add(&bar[XB_XSUB(b.x)], 1u);
        const unsigned gen = old / nloc;
        if (old + 1u == (gen + 1u) * nloc) {
            __builtin_amdgcn_fence(__ATOMIC_RELEASE, "agent");
            asm volatile("s_waitcnt vmcnt(0)" ::: "memory");
            const unsigned og = xb_add(&bar[XB_TOP], 1u);
            const unsigned tg = og / nx;
            if (og + 1u == (tg + 1u) * nx) xb_add(&bar[XB_TOPGEN], 1u);
            else XB_SPIN(xb_ld(&bar[XB_TOPGEN]) == tg, bar);
            __builtin_amdgcn_fence(__ATOMIC_ACQUIRE, "agent");
            xb_add(&bar[XB_XGEN(b.x)], 1u);
            asm volatile("s_waitcnt vmcnt(0)" ::: "memory");
        } else {
            XB_SPIN(xb_ld(&bar[XB_XGEN(b.x)]) == gen, bar);
            __builtin_amdgcn_fence(__ATOMIC_ACQUIRE, "agent");
            asm volatile("s_waitcnt vmcnt(0)" ::: "memory");
        }
    }
    __syncthreads();
}

template <bool GAIN>
__device__ __forceinline__ void transpose_item(const float* W, int N, bf16_t* WT, int ldt, int k0, int n0, int drow0, const float* gain, LAS float* scr, int lane) {
    float w[32];
#pragma unroll
    for (int i = 0; i < 32; ++i) w[i] = W[(size_t)(k0 + 2 * i + (lane >> 5)) * N + n0 + (lane & 31)];
    const int c = lane & 7;
    f32x4 g0 = {1.f, 1.f, 1.f, 1.f}, g1 = g0;
    if (GAIN) { g0 = *(const f32x4*)(gain + k0 + 8 * c); g1 = *(const f32x4*)(gain + k0 + 8 * c + 4); }
#pragma unroll
    for (int i = 0; i < 32; ++i) scr[(2 * i + (lane >> 5)) * 33 + (lane & 31)] = w[i];
    LDS_WAIT(); asm volatile("" ::: "memory");
#pragma unroll
    for (int j = 0; j < 4; ++j) { const int n = (lane >> 3) + 8 * j; const LAS float* s = scr + (8 * c) * 33 + n;
        u32x4 o; o.x = cvtpk(s[0 * 33] * g0[0], s[1 * 33] * g0[1]); o.y = cvtpk(s[2 * 33] * g0[2], s[3 * 33] * g0[3]); o.z = cvtpk(s[4 * 33] * g1[0], s[5 * 33] * g1[1]); o.w = cvtpk(s[6 * 33] * g1[2], s[7 * 33] * g1[3]);
        *(u32x4*)(WT + (size_t)(drow0 + n) * ldt + k0 + 8 * c) = o; }
    LDS_WAIT(); asm volatile("" ::: "memory");
}

struct Args { const float* in[19]; float* out; unsigned char* ws; int ph_lo, ph_hi; };
constexpr int N_PHASES = 21;

__global__ void __launch_bounds__(NTHR, 2) mega_fwd(Args args) {
    extern __shared__ __attribute__((aligned(16))) unsigned char lds_raw[];
    LAS unsigned char* lds = (LAS unsigned char*)lds_raw;
    const int G = gridDim.x, bx = blockIdx.x;
    const int vcu = (G % 8 == 0) ? (bx % 8) * (G / 8) + bx / 8 : bx;
    for (int u = threadIdx.x; u < (LDS_BYTES - LDSCTL_OFF) / 4; u += NTHR) ((LAS unsigned*)(lds + LDSCTL_OFF))[u] = 0u;
    __syncthreads();
    XcdBarrier bar; bar.bar = (unsigned*)(args.ws + WS_CTL) + CW_BAR; bar.x = 0; bar.st = nullptr;
    if (MK_N_LAUNCHES == 1) bar = xcd_barrier_post((unsigned*)(args.ws + WS_CTL) + CW_BAR, (volatile LAS unsigned*)(lds + MISC_OFF) + 8);

#define IDS() int tid = threadIdx.x; asm volatile("" : "+v"(tid)); const int lane = tid & 63, wave = __builtin_amdgcn_readfirstlane(tid >> 6); \
    const int gw = vcu * NWAVES + wave, NGW = G * NWAVES, gtid = vcu * NTHR + tid, NGT = G * NTHR, mw = (G - 1 - bx) * NWAVES + wave; \
    (void)lane; (void)gw; (void)NGW; (void)gtid; (void)NGT; (void)mw

    for (int ph = args.ph_lo; ph < args.ph_hi; ++ph) {
        unsigned long long zoff = 0; asm volatile("" : "+s"(zoff));
        unsigned char* ws = args.ws + zoff;
        const float* x = args.in[0]; const float* meta_tok = args.in[1]; const float* rel_table = args.in[2];
        const float* norm_mix = args.in[3]; const float* norm_ffn = args.in[4]; const float* norm_final = args.in[5];
        const float* bqkv = args.in[7]; const float* bo = args.in[9]; const float* sinks = args.in[10];
        const float* conv_w = args.in[12]; const float* pool_scale = args.in[15];
        float* dout = args.out;
        float* hmeta = (float*)(ws + WS_HMETA); float* ssq = (float*)(ws + WS_SSQ); float* ssqm = (float*)(ws + WS_SSQM); float* TB = (float*)(ws + WS_TB);
        bf16_t* HB = (bf16_t*)(ws + WS_HB); unsigned char* wts = ws + WS_W; unsigned char* big = ws + WS_BIG;
        const int nrep = ((PROBE_MASK >> ph) & 1u) ? 2 : 1;
        for (int prep = 0; prep < nrep; ++prep) {
        const bool dry = prep + 1 < nrep;
        bf16_t* r_hb = dry ? (bf16_t*)(ws + 229 * MiB) : HB; float* r_ssq = dry ? (float*)(ws + 237 * MiB) : ssq; const int r_mask = dry ? 4095 : -1;
        float* r_fout = ph == 19 ? (dry ? (float*)(ws + 213 * MiB) : dout) : nullptr;
        if (ph == 0) {
            IDS();
            LAS float* scr = (LAS float*)(lds + wave * 16384);
            constexpr int I_ATT = 768 + 512, I_CONV = 1536 + 512, I_POOL = 128, I_FFN = 3 * 1408, NITEMS = 2 * I_ATT + I_CONV + I_POOL + 4 * I_FFN;
            for (int it = gw; it < NITEMS; it += NGW) {
                int r = it;
                if (r < 2 * I_ATT) {
                    const int j = r / I_ATT; r -= j * I_ATT; unsigned char* wl = wts + j * W_ATT_STRIDE;
                    if (r < 768) { const int kb = r / 48, nb = r % 48; transpose_item<true>(args.in[6] + (size_t)j * D * NQKV, NQKV, (bf16_t*)(wl + W_QKV), D, 64 * kb, 32 * nb, 32 * nb, norm_mix + (size_t)(3 * j) * D, scr, lane); }
                    else { r -= 768; const int kb = r / 32, nb = r % 32; transpose_item<false>(args.in[8] + (size_t)j * D * D, D, (bf16_t*)(wl + W_O), D, 64 * kb, 32 * nb, 32 * nb, nullptr, scr, lane); }
                    continue;
                }
                r -= 2 * I_ATT;
                if (r < I_CONV) {
                    if (r < 1536) { const int kb = r / 96, nb = r % 96, n0 = 32 * nb; int drow;
                        if (n0 < 1024) drow = n0; else { const int c = (n0 - 1024) & 1023, isu = n0 >= 2048 ? 1 : 0; drow = 1024 + 256 * (c >> 7) + 128 * isu + (c & 127); }
                        transpose_item<true>(args.in[11], 3 * D, (bf16_t*)(wts + W_CIN), D, 64 * kb, n0, drow, norm_mix + (size_t)1 * D, scr, lane); }
                    else { r -= 1536; const int kb = r / 32, nb = r % 32; transpose_item<false>(args.in[13], D, (bf16_t*)(wts + W_COUT), D, 64 * kb, 32 * nb, 32 * nb, nullptr, scr, lane); }
                    continue;
                }
                r -= I_CONV;
                if (r < I_POOL) { const int gi = r / 32; r -= gi * 32; const int kb = r / 8, nb = r % 8;
                    transpose_item<false>(args.in[14] + (size_t)gi * 256 * 256, 256, (bf16_t*)(wts + W_POOL), 256, 64 * kb, 32 * nb, gi * 256 + 32 * nb, nullptr, scr, lane); continue; }
                r -= I_POOL;
                { const int i = r / I_FFN; r -= i * I_FFN; unsigned char* wl = wts + W_FFN + i * W_FFN_STRIDE;
                  if (r < 2816) { const int isu = r >= 1408 ? 1 : 0; r -= isu * 1408; const int kb = r / 88, nb = r % 88, n0 = 32 * nb;
                      transpose_item<true>(args.in[16 + isu] + (size_t)i * D * FF, FF, (bf16_t*)(wl + W_GU), D, 64 * kb, n0, 256 * (n0 >> 7) + 128 * isu + (n0 & 127), norm_ffn + (size_t)i * D, scr, lane); }
                  else { r -= 2816; const int kb = r / 32, nb = r % 32; transpose_item<false>(args.in[18] + (size_t)i * FF * D, D, (bf16_t*)(wl + W_DN), FF, 64 * kb, 32 * nb, 32 * nb, nullptr, scr, lane); } }
            }
            for (int i = gtid; i < NH * 256; i += NGT) { const int h = i >> 8, dist = i & 255; TB[i] = rel_table[bucket_of(dist) * NH + h] * LOG2E; }
            for (int r0 = gw * 4; r0 < MT; r0 += NGW * 4) {
                f32x4 v[4][4];
#pragma unroll
                for (int q = 0; q < 4; ++q) { const int r = r0 + q; const float* src = r < MR ? x + (size_t)r * D : meta_tok + (size_t)(r - MR) * D; const f32x4* xr = (const f32x4*)src + lane;
#pragma unroll
                    for (int j = 0; j < 4; ++j) v[q][j] = xr[64 * j]; }
#pragma unroll
                for (int q = 0; q < 4; ++q) { const int r = r0 + q; float s = 0.f;
#pragma unroll
                    for (int j = 0; j < 4; ++j) s += (v[q][j][0] * v[q][j][0] + v[q][j][1] * v[q][j][1]) + (v[q][j][2] * v[q][j][2] + v[q][j][3] * v[q][j][3]);
                    s = wave_sum(s);
                    u32x2* o8 = (u32x2*)(HB + (size_t)r * D) + lane;
#pragma unroll
                    for (int j = 0; j < 4; ++j) { u32x2 w; w.x = cvtpk(v[q][j][0], v[q][j][1]); w.y = cvtpk(v[q][j][2], v[q][j][3]); o8[64 * j] = w; }
                    if (r >= MR) { f32x4* hm = (f32x4*)(hmeta + (size_t)(r - MR) * D) + lane;
#pragma unroll
                        for (int j = 0; j < 4; ++j) hm[64 * j] = v[q][j]; }
                    if (r < MR) { if (lane < 16) ssq[(size_t)r * 16 + lane] = lane == 0 ? s : 0.f; } else ssqm[(r - MR) * 64 + lane] = lane == 0 ? s : 0.f; }
            }
        } else if (ph == 20) {
            IDS();
            for (int r0 = gw * 4; r0 < MR; r0 += NGW * 4) {
                f32x4 v[4][4]; float p[4];
#pragma unroll
                for (int q = 0; q < 4; ++q) { const int r = r0 + q; p[q] = lane < 16 ? ssq[(size_t)r * 16 + lane] : 0.f; const f32x4* xr = (const f32x4*)(dout + (size_t)r * D) + lane;
#pragma unroll
                    for (int j = 0; j < 4; ++j) v[q][j] = xr[64 * j]; }
                const f32x4* gr = (const f32x4*)norm_final + lane; f32x4 gg[4];
#pragma unroll
                for (int j = 0; j < 4; ++j) gg[j] = gr[64 * j];
#pragma unroll
                for (int q = 0; q < 4; ++q) { const float rs = 1.0f / sqrtf(wave_sum(p[q]) * (1.0f / D) + EPS); f32x4* xr = (f32x4*)(dout + (size_t)(r0 + q) * D) + lane;
#pragma unroll
                    for (int j = 0; j < 4; ++j) xr[64 * j] = v[q][j] * rs * gg[j]; }
            }
        } else {
            const int li = ph <= 5 ? 0 : (ph <= 10 ? 1 : (ph <= 14 ? 2 : 3));
            const int first = li == 0 ? 1 : (li == 1 ? 6 : (li == 2 ? 11 : 15));
            const int last = li == 0 ? 5 : (li == 1 ? 10 : (li == 2 ? 14 : 19));
            unsigned char* wffn = wts + W_FFN + li * W_FFN_STRIDE;
            if (ph == last - 1) {
                { IDS(); pg8::Gemm g{HB, (const bf16_t*)(wffn + W_GU), D, D, D, 0}; pg8::StaticOrder So; So.init(64, 22, G, bx);
                  pg8::EpiSwiGLU E{(bf16_t*)big, ssq};
                  pg8::gemm_phase<pg8::EpiSwiGLU>(lds, g, So, E, tid); }
                { IDS(); for (int task = mw; task < 176; task += NGW) meta::task_gu(task, HB, (const bf16_t*)(wffn + W_GU), ssqm, (bf16_t*)big, lane); }
            } else if (ph == last) {
                { IDS(); pg8::Gemm g{(const bf16_t*)big, (const bf16_t*)(wffn + W_DN), FF, FF, FF, 0}; pg8::StaticOrder So; So.init(64, 4, G, bx);
                  pg8::EpiResid E{HB, r_hb, r_fout, r_ssq, nullptr, nullptr, r_mask};
                  pg8::gemm_phase<pg8::EpiResid>(lds, g, So, E, tid); }
                if (!dry) { IDS(); for (int task = mw; task < 64; task += NGW) meta::task_res(task, (const bf16_t*)big, FF, 0, (const bf16_t*)(wffn + W_DN), FF, FF, nullptr, nullptr, hmeta, HB, ssqm, lane); }
            } else if (li == 0 || li == 3) {
                const int j = li == 0 ? 0 : 1; unsigned char* wl = wts + j * W_ATT_STRIDE;
                bf16_t* qkv = (bf16_t*)(big + BIG_QKV); bf16_t* ob = (bf16_t*)(big + BIG_O);
                if (ph == first) {
                    { IDS(); pg8::Gemm g{HB, (const bf16_t*)(wl + W_QKV), D, D, D, 0}; pg8::StaticOrder So; So.init(64, 6, G, bx);
                      pg8::EpiQKV E{qkv, bqkv + (size_t)j * NQKV, ssq};
                      pg8::gemm_phase<pg8::EpiQKV>(lds, g, So, E, tid); }
                    { IDS(); for (int task = mw; task < 96; task += NGW) meta::task_qkv(task, HB, (const bf16_t*)(wl + W_QKV), bqkv + (size_t)j * NQKV, ssqm, qkv, lane); }
                } else if (ph == first + 1) {
                    for (int ui = vcu; ui < NB * NKV * 64 + NKV; ui += G) {
                        const bool mq = ui >= NB * NKV * 64; const int nblk = mq ? 64 : (ui & 63), bk = mq ? (ui - NB * NKV * 64) : (ui >> 6);
                        att::unit(lds, qkv, ob, TB, sinks + (size_t)j * NH, bk >> 2, bk & 3, nblk, threadIdx.x);
                    }
                } else {
                    { IDS(); pg8::Gemm g{ob, (const bf16_t*)(wl + W_O), D, D, D, 0}; pg8::StaticOrder So; So.init(64, 4, G, bx);
                      pg8::EpiResid E{HB, r_hb, nullptr, r_ssq, bo + (size_t)j * D, nullptr, r_mask};
                      pg8::gemm_phase<pg8::EpiResid>(lds, g, So, E, tid); }
                    if (!dry) { IDS(); for (int task = mw; task < 64; task += NGW) meta::task_res(task, ob, D, 0, (const bf16_t*)(wl + W_O), D, D, bo + (size_t)j * D, nullptr, hmeta, HB, ssqm, lane); }
                }
            } else if (li == 1) {
                bf16_t* GBb = (bf16_t*)(big + BIG_GB); bf16_t* Zb = (bf16_t*)(big + BIG_Z); bf16_t* Gb = (bf16_t*)(big + BIG_G);
                if (ph == first) {
                    { IDS(); pg8::Gemm g{HB, (const bf16_t*)(wts + W_CIN), D, D, D, 0}; pg8::StaticOrder So; So.init(64, 12, G, bx);
                      pg8::EpiConvIn E{GBb, Zb, ssq};
                      pg8::gemm_phase<pg8::EpiConvIn>(lds, g, So, E, tid); }
                    { IDS(); for (int task = mw; task < 128; task += NGW) meta::task_cin(task, HB, (const bf16_t*)(wts + W_CIN), ssqm, GBb, Zb, lane); }
                } else if (ph == first + 1) {
                    IDS();
                    for (int it = gtid; it < MT * 128; it += NGT) {
                        const int r = it >> 7, c8 = (it & 127) * 8;
                        int r1, r2;
                        if (r < MR) { const int s = r & (S - 1); r1 = s >= 1 ? r - 1 : MR + 15; r2 = s >= 2 ? r - 2 : MR + 14 + s; }
                        else { const int m = (r - MR) & 15; r1 = m >= 1 ? r - 1 : -1; r2 = m >= 2 ? r - 2 : -1; }
                        const u32x4 z0 = *(const u32x4*)(Zb + (size_t)r * D + c8);
                        u32x4 z1 = (u32x4){0u, 0u, 0u, 0u}, z2 = (u32x4){0u, 0u, 0u, 0u};
                        if (r1 >= 0) z1 = *(const u32x4*)(Zb + (size_t)r1 * D + c8);
                        if (r2 >= 0) z2 = *(const u32x4*)(Zb + (size_t)r2 * D + c8);
                        const u32x4 gb = *(const u32x4*)(GBb + (size_t)r * D + c8);
                        const float* w0 = conv_w + c8; const float* w1 = conv_w + D + c8; const float* w2 = conv_w + 2 * D + c8;
                        u32x4 ov;
#pragma unroll
                        for (int e = 0; e < 4; ++e) {
                            const unsigned a0 = z0[e], a1 = z1[e], a2 = z2[e], ag = gb[e];
                            const float lo = bf2f((unsigned short)(ag & 0xffffu)) * (w2[2 * e] * bf2f((unsigned short)(a0 & 0xffffu)) + w1[2 * e] * bf2f((unsigned short)(a1 & 0xffffu)) + w0[2 * e] * bf2f((unsigned short)(a2 & 0xffffu)));
                            const float hi = bf2f((unsigned short)(ag >> 16)) * (w2[2 * e + 1] * bf2f((unsigned short)(a0 >> 16)) + w1[2 * e + 1] * bf2f((unsigned short)(a1 >> 16)) + w0[2 * e + 1] * bf2f((unsigned short)(a2 >> 16)));
                            ov[e] = cvtpk(lo, hi);
                        }
                        *(u32x4*)(Gb + (size_t)r * D + c8) = ov;
                    }
                } else {
                    { IDS(); pg8::Gemm g{Gb, (const bf16_t*)(wts + W_COUT), D, D, D, 0}; pg8::StaticOrder So; So.init(64, 4, G, bx);
                      pg8::EpiResid E{HB, r_hb, nullptr, r_ssq, nullptr, nullptr, r_mask};
                      pg8::gemm_phase<pg8::EpiResid>(lds, g, So, E, tid); }
                    if (!dry) { IDS(); for (int task = mw; task < 64; task += NGW) meta::task_res(task, Gb, D, 0, (const bf16_t*)(wts + W_COUT), D, D, nullptr, nullptr, hmeta, HB, ssqm, lane); }
                }
            } else {
                bf16_t* MIX = (bf16_t*)big;
                if (ph == first) {
                    IDS();
                    LAS float* rsl = (LAS float*)lds;
                    const float* gmix = norm_mix + (size_t)2 * D;
                    for (int ui = vcu; ui < NB * 128 + 1; ui += G) {
                        const bool mq = ui >= NB * 128; const int b = mq ? 0 : (ui >> 7), t0 = mq ? 0 : NMETA + (ui & 127) * 64;
                        __syncthreads();
                        if (tid < 79) { const int t = t0 - 15 + tid; float rs = 0.f;
                            if (t >= 0 && t < LSEQ) { const int row = rowof(b, t); float s = 0.f;
                                if (row < MR) { const f32x4* p = (const f32x4*)(ssq + (size_t)row * 16);
#pragma unroll
                                    for (int k = 0; k < 4; ++k) { const f32x4 a = p[k]; s += (a[0] + a[1]) + (a[2] + a[3]); } }
                                else { const f32x4* p = (const f32x4*)(ssqm + (size_t)(row - MR) * 64);
#pragma unroll
                                    for (int k = 0; k < 16; ++k) { const f32x4 a = p[k]; s += (a[0] + a[1]) + (a[2] + a[3]); } }
                                rs = 1.0f / sqrtf(s * (1.0f / D) + EPS); }
                            rsl[tid] = rs; }
                        __syncthreads();
                        const int c = 2 * tid, win = 2 << (c >> 8);
                        const f32x2 gg = *(const f32x2*)(gmix + c);
#define POOL_A(t) ({ const int _t = (t); f32x2 _a = (f32x2){0.f, 0.f}; if (_t >= 0) { const int _row = rowof(b, _t); const unsigned _hb = *(const unsigned*)(HB + (size_t)_row * D + c); \
                            const f32x2 _h = (f32x2){__builtin_bit_cast(float, _hb << 16), __builtin_bit_cast(float, _hb & 0xffff0000u)}; const float _rs = rsl[_t - (t0 - 15)]; _a = _h * _rs * gg; } _a; })
                        f32x2 Ssum = (f32x2){0.f, 0.f};
                        for (int jj = 1; jj < win; ++jj) Ssum += POOL_A(t0 - jj);
                        const int tend = mq ? NMETA : t0 + 64;
                        for (int t = t0; t < tend; ++t) {
                            const f32x2 at = POOL_A(t); Ssum += at;
                            const int cnt = win < t + 1 ? win : t + 1; const float ic = 1.0f / (float)cnt;
                            const f32x2 mx = Ssum * ic - at;
                            *(unsigned*)(MIX + (size_t)rowof(b, t) * D + c) = cvtpk(mx[0], mx[1]);
                            Ssum -= POOL_A(t - win + 1);
                        }
#undef POOL_A
                    }
                    __syncthreads();
                } else {
                    { IDS(); pg8::Gemm g{MIX, (const bf16_t*)(wts + W_POOL), D, 256, 256, 256}; pg8::StaticOrder So; So.init(64, 4, G, bx);
                      pg8::EpiResid E{HB, r_hb, nullptr, r_ssq, nullptr, pool_scale, r_mask};
                      pg8::gemm_phase<pg8::EpiResid>(lds, g, So, E, tid); }
                    if (!dry) { IDS(); for (int task = mw; task < 64; task += NGW) meta::task_res(task, MIX, D, 256, (const bf16_t*)(wts + W_POOL), 256, 256, nullptr, pool_scale, hmeta, HB, ssqm, lane); }
                }
            }
        }
        if (MK_N_LAUNCHES == 1 && dry) xcd_barrier(bar);
        }
        if (MK_N_LAUNCHES == 1 && ph + 1 < args.ph_hi) { xcd_barrier(bar); for (int xb = 0; xb < PROBE_XBAR; ++xb) xcd_barrier(bar); }
    }
#undef IDS
}

extern "C" void kernel_launch(void* const* d_in, const int* in_sizes, int n_in, void* d_out, int out_size, void* d_ws, size_t ws_size, hipStream_t stream) {
    static int grid = 0;
    if (grid == 0) {
        if (n_in != 19 || out_size != MR * D || ws_size < WS_END) { fprintf(stderr, "kernel_launch: unexpected shapes (n_in %d out %d ws %zu)\n", n_in, out_size, ws_size); grid = -1; return; }
        int dev = 0, cus = 0, per_cu = 0;
        if (hipGetDevice(&dev) != hipSuccess || hipDeviceGetAttribute(&cus, hipDeviceAttributeMultiprocessorCount, dev) != hipSuccess) { grid = -1; return; }
        if (hipFuncSetAttribute((const void*)mega_fwd, hipFuncAttributeMaxDynamicSharedMemorySize, LDS_BYTES) != hipSuccess) { fprintf(stderr, "kernel_launch: hipFuncSetAttribute failed\n"); grid = -1; return; }
        if (hipOccupancyMaxActiveBlocksPerMultiprocessor(&per_cu, (const void*)mega_fwd, NTHR, LDS_BYTES) != hipSuccess || per_cu < 1) { fprintf(stderr, "kernel_launch: occupancy query says %d blocks/CU\n", per_cu); }
        (void)hipGetLastError();
        grid = cus;
    }
    if (grid < 0) return;
    if (hipMemsetAsync((char*)d_ws + WS_CTL, 0, CTL_ZERO_BYTES, stream) != hipSuccess) { fprintf(stderr, "kernel_launch: memset failed\n"); return; }
    Args a{};
    for (int i = 0; i < 19; ++i) a.in[i] = (const float*)d_in[i];
    a.out = (float*)d_out; a.ws = (unsigned char*)d_ws;
    if (MK_N_LAUNCHES == 1) {
        a.ph_lo = 0; a.ph_hi = N_PHASES;
        hipLaunchKernelGGL(mega_fwd, dim3(grid), dim3(NTHR), LDS_BYTES, stream, a);
    } else {
        for (int ph = 0; ph < N_PHASES; ++ph) { a.ph_lo = ph; a.ph_hi = ph + 1; hipLaunchKernelGGL(mega_fwd, dim3(grid), dim3(NTHR), LDS_BYTES, stream, a); }
    }
}
```

```cpp
#include <hip/hip_runtime.h>
#include <cstdio>
#include <cstdint>

#ifndef MK_N_LAUNCHES
#define MK_N_LAUNCHES 1
#endif
#ifndef PROBE_MASK
#define PROBE_MASK 0u
#endif
#ifndef PROBE_XBAR
#define PROBE_XBAR 0
#endif

#define LAS __attribute__((address_space(3)))
#define GAS __attribute__((address_space(1)))
typedef unsigned short bf16_t;
typedef short bf16x8 __attribute__((ext_vector_type(8)));
typedef short s16x4 __attribute__((ext_vector_type(4)));
typedef float f32x2 __attribute__((ext_vector_type(2)));
typedef float f32x4 __attribute__((ext_vector_type(4)));
typedef float f32x16 __attribute__((ext_vector_type(16)));
typedef unsigned u32x2 __attribute__((ext_vector_type(2)));
typedef unsigned u32x4 __attribute__((ext_vector_type(4)));
typedef __bf16 bf16x2_t __attribute__((ext_vector_type(2)));

constexpr int D = 1024, NB = 2, S = 8192, NMETA = 16, LSEQ = S + NMETA;
constexpr int MR = NB * S;
constexpr int MT = MR + NMETA;
constexpr int MP = 65 * 256;
constexpr int NH = 16, NKV = 4, HD = 64, NQKV = 1536, FF = 2816;
constexpr float EPS = 1e-6f;
constexpr float LOG2E = 1.4426950408889634f;
constexpr float QSCALE = 0.125f * LOG2E;
constexpr int NWAVES = 8, NTHR = 512;

constexpr size_t MiB = 1u << 20;
constexpr size_t WS_CTL = 0, CTL_ZERO_BYTES = 1 * MiB;
constexpr size_t WS_HMETA = 1 * MiB;
constexpr size_t WS_SSQ = 2 * MiB;
constexpr size_t WS_SSQM = 3 * MiB + 512 * 1024;
constexpr size_t WS_TB = 4 * MiB;
constexpr size_t WS_W = 5 * MiB;
constexpr size_t W_QKV = 0, W_O = 3 * MiB, W_ATT_STRIDE = 5 * MiB;
constexpr size_t W_CIN = 10 * MiB, W_COUT = 16 * MiB, W_POOL = 18 * MiB;
constexpr size_t W_FFN = 19 * MiB, W_FFN_STRIDE = 33 * MiB / 2, W_GU = 0, W_DN = 11 * MiB;
constexpr size_t WS_HB = 90 * MiB;
constexpr size_t WS_BIG = 123 * MiB;
constexpr size_t BIG_QKV = 0, BIG_O = 49 * MiB;
constexpr size_t BIG_GB = 0, BIG_Z = 33 * MiB, BIG_G = 66 * MiB;
constexpr size_t WS_HB2 = 213 * MiB;
constexpr size_t WS_END = 256 * MiB;
static_assert(W_FFN + 4 * W_FFN_STRIDE <= 85 * MiB && WS_W + 85 * MiB <= WS_HB, "weights");
static_assert(WS_HB + (size_t)MP * D * 2 <= WS_BIG && WS_BIG + (size_t)MP * FF * 2 <= WS_END, "ws map");

constexpr int CW_BAR = 4096;

constexpr int RING_BYTES = 131072;
constexpr int LDSCTL_OFF = RING_BYTES, MISC_OFF = LDSCTL_OFF + 320;
constexpr int LDS_BYTES = 147456;

__device__ __forceinline__ unsigned cvtpk(float lo, float hi) { f32x2 v = {lo, hi}; bf16x2_t b = __builtin_convertvector(v, bf16x2_t); return __builtin_bit_cast(unsigned, b); }
__device__ __forceinline__ float bf2f(unsigned short u) { return __builtin_bit_cast(float, (unsigned)u << 16); }
__device__ __forceinline__ float wave_sum(float v) {
#pragma unroll
    for (int o = 1; o < 64; o <<= 1) v += __shfl_xor(v, o);
    return v;
}
__device__ __forceinline__ int rowof(int b, int t) { return t < NMETA ? MR + t : b * S + (t - NMETA); }
__device__ __forceinline__ int bucket_of(int dist) {
    if (dist < 16) return dist < 0 ? 0 : dist;
    int v = 16 + (int)(log2f((float)dist * 0.0625f) * (16.0f / 3.0f));
    return v > 31 ? 31 : v;
}
#define LDS_WAIT() asm volatile("s_waitcnt lgkmcnt(0)" ::: "memory")
#define VM_WAIT() asm volatile("s_waitcnt vmcnt(0)" ::: "memory")

namespace pg8 {
constexpr int BM = 256, BK = 64, HALF = 128, HTB = HALF * BK * 2, STAGE_BYTES = 8 * HTB, NXCD = 8, WGM = 8;
__host__ __device__ __forceinline__ int lds_byte(int r, int c) { const int st = (r >> 4) * 2 + (c >> 5), rr = r & 15, cc = c & 31, ob = rr * 64 + cc * 2; return st * 1024 + (ob ^ (((ob >> 9) & 1) << 5)); }
__host__ __device__ __forceinline__ void stage_rc(int b, int& R, int& C) { const int st = b / 1024, sb = b % 1024, swz = sb ^ (((sb >> 9) & 1) << 5); R = (st >> 1) * 16 + swz / 64; C = (st & 1) * 32 + (swz % 64) / 2; }
__host__ __device__ __forceinline__ int perm32(int rho) { const int n = rho >> 4, i = rho & 15; return 8 * (i >> 2) + 4 * n + (i & 3); }

struct Unit { int pm, pn; };
struct Gemm { const bf16_t* A; const bf16_t* Bt; int lda, ldb, K, a_pn_off; };

struct StaticOrder {
    int nM, nN, nwg, G, c;
    __device__ void init(int nM_, int nN_, int G_, int c_) { nM = nM_; nN = nN_; nwg = nM * nN; G = G_; c = c_; }
    __device__ bool next(int i, Unit& u) const {
        const long L = (long)i * G + c; if (L >= nwg) return false;
        int wgid = (int)L; { const int q = nwg / NXCD, r = nwg % NXCD, xcd = wgid % NXCD, off = wgid / NXCD; wgid = (xcd < r ? xcd * (q + 1) : r * (q + 1) + (xcd - r) * q) + off; }
        const int nig = WGM * nN, gid = wgid / nig, fm = gid * WGM, gsz = (nM - fm) < WGM ? (nM - fm) : WGM;
        u.pm = fm + ((wgid % nig) % gsz); u.pn = (wgid % nig) / gsz; return true;
    }
};

__device__ __forceinline__ float rstd_of(const float* ssq, int row) {
    const f32x4* p = (const f32x4*)(ssq + (size_t)row * 16);
    const f32x4 a = p[0], b = p[1], c = p[2], d = p[3];
    const float s = ((a[0] + a[1]) + (a[2] + a[3])) + ((b[0] + b[1]) + (b[2] + b[3])) + ((c[0] + c[1]) + (c[2] + c[3])) + ((d[0] + d[1]) + (d[2] + d[3]));
    return __builtin_amdgcn_rsqf(s * (1.0f / D) + EPS);
}

struct EpiQKV {
    static constexpr bool PERM = true;
    bf16_t* O; const float* bias; const float* ssq;
    __device__ __forceinline__ void operator()(const f32x4 (&acc)[2][2][4][2], const Unit& u, int wr, int wc, int fr, int fq) const {
        const int row0 = u.pm * BM + wr * 64 + fr, col0 = u.pn * BM + wc * 32 + 8 * fq;
        const float sc = u.pn < 4 ? QSCALE : 1.0f;
        f32x4 bv[2][2];
#pragma unroll
        for (int bj = 0; bj < 2; ++bj)
#pragma unroll
            for (int n = 0; n < 2; ++n) bv[bj][n] = *(const f32x4*)(bias + col0 + bj * HALF + 4 * n);
#pragma unroll
        for (int ai = 0; ai < 2; ++ai)
#pragma unroll
            for (int m = 0; m < 4; ++m) {
                const int row = row0 + ai * HALF + m * 16; const float rs = rstd_of(ssq, row);
                bf16_t* rowp = O + (size_t)row * NQKV + col0;
#pragma unroll
                for (int bj = 0; bj < 2; ++bj) {
                    const f32x4 v0 = (acc[ai][bj][m][0] * rs + bv[bj][0]) * sc, v1 = (acc[ai][bj][m][1] * rs + bv[bj][1]) * sc;
                    u32x4 w; w.x = cvtpk(v0[0], v0[1]); w.y = cvtpk(v0[2], v0[3]); w.z = cvtpk(v1[0], v1[1]); w.w = cvtpk(v1[2], v1[3]);
                    *(u32x4*)(rowp + bj * HALF) = w;
                }
            }
    }
};
__device__ __forceinline__ float silu_mul(float g, float u) { return g * __builtin_amdgcn_rcpf(1.0f + __builtin_amdgcn_exp2f(-g * LOG2E)) * u; }
struct EpiSwiGLU {
    static constexpr bool PERM = true;
    bf16_t* O; const float* ssq;
    __device__ __forceinline__ void operator()(const f32x4 (&acc)[2][2][4][2], const Unit& u, int wr, int wc, int fr, int fq) const {
        const int row0 = u.pm * BM + wr * 64 + fr, col0 = u.pn * HALF + wc * 32 + 8 * fq;
#pragma unroll
        for (int ai = 0; ai < 2; ++ai)
#pragma unroll
            for (int m = 0; m < 4; ++m) {
                const int row = row0 + ai * HALF + m * 16; const float rs = rstd_of(ssq, row);
                const f32x4 g0 = acc[ai][0][m][0] * rs, g1 = acc[ai][0][m][1] * rs, u0 = acc[ai][1][m][0] * rs, u1 = acc[ai][1][m][1] * rs;
                u32x4 w; w.x = cvtpk(silu_mul(g0[0], u0[0]), silu_mul(g0[1], u0[1])); w.y = cvtpk(silu_mul(g0[2], u0[2]), silu_mul(g0[3], u0[3]));
                w.z = cvtpk(silu_mul(g1[0], u1[0]), silu_mul(g1[1], u1[1])); w.w = cvtpk(silu_mul(g1[2], u1[2]), silu_mul(g1[3], u1[3]));
                *(u32x4*)(O + (size_t)row * FF + col0) = w;
            }
    }
};
struct EpiConvIn {
    static constexpr bool PERM = true;
    bf16_t* GB; bf16_t* Z; const float* ssq;
    __device__ __forceinline__ void operator()(const f32x4 (&acc)[2][2][4][2], const Unit& u, int wr, int wc, int fr, int fq) const {
        const int row0 = u.pm * BM + wr * 64 + fr;
        if (u.pn < 4) {
            const int col0 = u.pn * BM + wc * 32 + 8 * fq;
#pragma unroll
            for (int ai = 0; ai < 2; ++ai)
#pragma unroll
                for (int m = 0; m < 4; ++m) {
                    const int row = row0 + ai * HALF + m * 16; const float rs = rstd_of(ssq, row);
                    bf16_t* rowp = GB + (size_t)row * D + col0;
#pragma unroll
                    for (int bj = 0; bj < 2; ++bj) {
                        const f32x4 v0 = acc[ai][bj][m][0] * rs, v1 = acc[ai][bj][m][1] * rs;
                        u32x4 w; w.x = cvtpk(v0[0], v0[1]); w.y = cvtpk(v0[2], v0[3]); w.z = cvtpk(v1[0], v1[1]); w.w = cvtpk(v1[2], v1[3]);
                        *(u32x4*)(rowp + bj * HALF) = w;
                    }
                }
        } else {
            const int col0 = (u.pn - 4) * HALF + wc * 32 + 8 * fq;
#pragma unroll
            for (int ai = 0; ai < 2; ++ai)
#pragma unroll
                for (int m = 0; m < 4; ++m) {
                    const int row = row0 + ai * HALF + m * 16; const float rs = rstd_of(ssq, row); const float r2 = rs * rs;
                    const f32x4 z0 = acc[ai][0][m][0] * acc[ai][1][m][0] * r2, z1 = acc[ai][0][m][1] * acc[ai][1][m][1] * r2;
                    u32x4 w; w.x = cvtpk(z0[0], z0[1]); w.y = cvtpk(z0[2], z0[3]); w.z = cvtpk(z1[0], z1[1]); w.w = cvtpk(z1[2], z1[3]);
                    *(u32x4*)(Z + (size_t)row * D + col0) = w;
                }
        }
    }
};
struct EpiResid {
    static constexpr bool PERM = false;
    const bf16_t* HBi; bf16_t* HBo; float* fout; float* ssq; const float* bias; const float* cscale; int rmask;
    __device__ __forceinline__ void operator()(const f32x4 (&acc)[2][2][4][2], const Unit& u, int wr, int wc, int fr, int fq) const {
        const int col0 = u.pn * BM + wc * 32 + 4 * fq;
        f32x4 bv[2][2], cs[2][2];
#pragma unroll
        for (int bj = 0; bj < 2; ++bj)
#pragma unroll
            for (int n = 0; n < 2; ++n) {
                bv[bj][n] = bias ? *(const f32x4*)(bias + col0 + bj * HALF + n * 16) : (f32x4){0.f, 0.f, 0.f, 0.f};
                cs[bj][n] = cscale ? *(const f32x4*)(cscale + col0 + bj * HALF + n * 16) : (f32x4){1.f, 1.f, 1.f, 1.f};
            }
        const size_t off0 = (size_t)(u.pm * BM + wr * 64 + fr) * D + col0;
        u32x2 cur[2][2], nxt[2][2];
#pragma unroll
        for (int bj = 0; bj < 2; ++bj)
#pragma unroll
            for (int n = 0; n < 2; ++n) cur[bj][n] = *(const u32x2*)(HBi + off0 + bj * HALF + n * 16);
#pragma unroll
        for (int gi = 0; gi < 8; ++gi) {
            const int ai = gi >> 2, m = gi & 3;
            if (gi < 7) { const size_t offn = off0 + (size_t)(((gi + 1) >> 2) * HALF + ((gi + 1) & 3) * 16) * D;
#pragma unroll
                for (int bj = 0; bj < 2; ++bj)
#pragma unroll
                    for (int n = 0; n < 2; ++n) nxt[bj][n] = *(const u32x2*)(HBi + offn + bj * HALF + n * 16); }
            const int srow = (u.pm * BM + ai * HALF + wr * 64 + m * 16 + fr) & rmask; const size_t soff = (size_t)srow * D + col0;
            float q = 0.f;
#pragma unroll
            for (int bj = 0; bj < 2; ++bj)
#pragma unroll
                for (int n = 0; n < 2; ++n) {
                    const u32x2 hb = cur[bj][n];
                    const f32x4 h4 = (f32x4){__builtin_bit_cast(float, hb.x << 16), __builtin_bit_cast(float, hb.x & 0xffff0000u), __builtin_bit_cast(float, hb.y << 16), __builtin_bit_cast(float, hb.y & 0xffff0000u)};
                    const f32x4 v = h4 + (acc[ai][bj][m][n] + bv[bj][n]) * cs[bj][n];
                    if (fout) *(f32x4*)(fout + soff + bj * HALF + n * 16) = v;
                    u32x2 w; w.x = cvtpk(v[0], v[1]); w.y = cvtpk(v[2], v[3]);
                    *(u32x2*)(HBo + soff + bj * HALF + n * 16) = w;
                    q += (v[0] * v[0] + v[1] * v[1]) + (v[2] * v[2] + v[3] * v[3]);
                }
            q += __shfl_xor(q, 16); q += __shfl_xor(q, 32);
            if (fq == 0) ssq[(size_t)srow * 16 + u.pn * 4 + wc] = q;
#pragma unroll
            for (int bj = 0; bj < 2; ++bj)
#pragma unroll
                for (int n = 0; n < 2; ++n) cur[bj][n] = nxt[bj][n];
        }
    }
};

template <class Epi>
__device__ __forceinline__ void gemm_phase(LAS unsigned char* lds, const Gemm g, const StaticOrder& S, const Epi& E, const int tid) {
    const int wid = __builtin_amdgcn_readfirstlane(tid >> 6), lane = tid & 63, wr = wid >> 2, wc = wid & 3, fr = lane & 15, fq = lane >> 4;
    const int K = g.K, nt = K / BK;
    unsigned voffA[2], voffB[2];
#pragma unroll
    for (int i = 0; i < 2; ++i) { int R, C; stage_rc(tid * 16 + i * 8192, R, C); const int Rb = Epi::PERM ? ((R & ~31) + perm32(R & 31)) : R;
        voffA[i] = (unsigned)(R * g.lda + C) * 2u; voffB[i] = (unsigned)(Rb * g.ldb + C) * 2u; }
    const size_t kstep = (size_t)(BK * 2);
    const size_t hstepA = (size_t)HALF * g.lda * 2, hstepB = (size_t)HALF * g.ldb * 2;
    const size_t tstepA = 2 * hstepA, tstepB = 2 * hstepB;
    const size_t pnoffA = (size_t)g.a_pn_off * 2;
    const unsigned ldsw = (unsigned)wid * 1024u;
    const int aoff = lds_byte(wr * 64 + fr, fq * 8), boff = lds_byte(wc * 32 + fr, fq * 8);
#define PG8_SA(b, h) (((b) * 2 + (h)) * HTB)
#define PG8_SB(b, h) ((4 + (b) * 2 + (h)) * HTB)
#define PG8_STAGE(bufoff, gbase, voff) do { _Pragma("unroll") for (int _i = 0; _i < 2; ++_i) \
        __builtin_amdgcn_global_load_lds((const unsigned*)((const char*)(gbase) + (voff)[_i]), (LAS unsigned*)(lds + (bufoff) + ldsw + _i * 8192), 16, 0, 0); } while (0)
#define PG8_LDA(dst, b, h) do { _Pragma("unroll") for (int m = 0; m < 4; ++m) _Pragma("unroll") for (int k = 0; k < 2; ++k) dst[m][k] = *(const LAS bf16x8*)(lds + PG8_SA(b, h) + aoff + m * 2048 + k * 1024); } while (0)
#define PG8_LDB(dst, b, h) do { _Pragma("unroll") for (int n = 0; n < 2; ++n) _Pragma("unroll") for (int k = 0; k < 2; ++k) dst[n][k] = *(const LAS bf16x8*)(lds + PG8_SB(b, h) + boff + n * 2048 + k * 1024); } while (0)
#define PG8_MMA(ai, bj, At, Bt) do { __builtin_amdgcn_s_setprio(1); _Pragma("unroll") for (int m = 0; m < 4; ++m) _Pragma("unroll") for (int n = 0; n < 2; ++n) _Pragma("unroll") for (int k = 0; k < 2; ++k) \
        acc[ai][bj][m][n] = __builtin_amdgcn_mfma_f32_16x16x32_bf16(Bt[n][k], At[m][k], acc[ai][bj][m][n], 0, 0, 0); __builtin_amdgcn_s_setprio(0); } while (0)
#define PG8_WAIT_V(n) asm volatile("s_waitcnt vmcnt(" #n ")" ::: "memory")
#define PG8_WAIT_L(n) asm volatile("s_waitcnt lgkmcnt(" #n ")" ::: "memory")
#define PG8_BAR __builtin_amdgcn_s_barrier()
#define PG8_SCHED __builtin_amdgcn_sched_barrier(0)
    Unit cur, nxt; int ui = 0;
    if (!S.next(0, cur)) return;
    f32x4 acc[2][2][4][2];
#pragma unroll
    for (int a = 0; a < 2; ++a)
#pragma unroll
        for (int b = 0; b < 2; ++b)
#pragma unroll
            for (int m = 0; m < 4; ++m)
#pragma unroll
                for (int n = 0; n < 2; ++n) acc[a][b][m][n] = (f32x4){0.f, 0.f, 0.f, 0.f};
    bf16x8 At[4][2], B0[2][2], B1[2][2];
    const char* cA = (const char*)g.A + (size_t)cur.pm * tstepA + (size_t)cur.pn * pnoffA; const char* cB = (const char*)g.Bt + (size_t)cur.pn * tstepB;
    PG8_STAGE(PG8_SB(0, 0), cB, voffB); PG8_STAGE(PG8_SB(0, 1), cB + hstepB, voffB); PG8_STAGE(PG8_SA(0, 0), cA, voffA); PG8_STAGE(PG8_SA(0, 1), cA + hstepA, voffA);
    if (wr == 1) PG8_BAR;
    PG8_WAIT_V(2); PG8_BAR;
    PG8_STAGE(PG8_SB(1, 0), cB + kstep, voffB); PG8_STAGE(PG8_SA(1, 0), cA + kstep, voffA); PG8_STAGE(PG8_SB(1, 1), cB + hstepB + kstep, voffB);
    PG8_WAIT_V(6); PG8_BAR;
    for (;;) {
        const bool has_next = S.next(ui + 1, nxt);
        const char* nA = has_next ? (const char*)g.A + (size_t)nxt.pm * tstepA + (size_t)nxt.pn * pnoffA : cA; const char* nB = has_next ? (const char*)g.Bt + (size_t)nxt.pn * tstepB : cB;
        for (int t = 0; t < nt; t += 2) {
            const bool last = (t == nt - 2);
            const char* a1 = cA + (size_t)(t + 1) * kstep;
            const char* a2 = last ? nA : cA + (size_t)(t + 2) * kstep; const char* b2 = last ? nB : cB + (size_t)(t + 2) * kstep;
            const char* a3 = a2 + kstep; const char* b3 = b2 + kstep;
            PG8_LDB(B0, 0, 0); PG8_LDB(B1, 0, 1); PG8_SCHED; PG8_LDA(At, 0, 0); PG8_STAGE(PG8_SA(1, 1), a1 + hstepA, voffA);
            PG8_WAIT_V(8); PG8_WAIT_L(0); PG8_BAR; PG8_MMA(0, 0, At, B0); PG8_MMA(0, 1, At, B1); PG8_BAR; PG8_SCHED;
            PG8_LDA(At, 0, 1); PG8_STAGE(PG8_SB(0, 0), b2, voffB); PG8_STAGE(PG8_SB(0, 1), b2 + hstepB, voffB); PG8_STAGE(PG8_SA(0, 0), a2, voffA);
            PG8_WAIT_V(8); PG8_WAIT_L(0); PG8_BAR; PG8_MMA(1, 0, At, B0); PG8_MMA(1, 1, At, B1); PG8_BAR; PG8_SCHED;
            PG8_LDB(B0, 1, 0); PG8_LDB(B1, 1, 1); PG8_SCHED; PG8_LDA(At, 1, 0); PG8_STAGE(PG8_SA(0, 1), a2 + hstepA, voffA);
            PG8_WAIT_V(8); PG8_WAIT_L(0); PG8_BAR; PG8_MMA(0, 0, At, B0); PG8_MMA(0, 1, At, B1); PG8_BAR; PG8_SCHED;
            PG8_LDA(At, 1, 1); PG8_STAGE(PG8_SB(1, 0), b3, voffB); PG8_STAGE(PG8_SB(1, 1), b3 + hstepB, voffB); PG8_STAGE(PG8_SA(1, 0), a3, voffA);
            PG8_WAIT_V(8); PG8_WAIT_L(0); PG8_BAR; PG8_MMA(1, 0, At, B0); PG8_MMA(1, 1, At, B1); PG8_BAR; PG8_SCHED;
        }
        if (wr == 0) PG8_BAR;
        E(acc, cur, wr, wc, fr, fq);
        if (!has_next) break;
#pragma unroll
        for (int a = 0; a < 2; ++a)
#pragma unroll
            for (int b = 0; b < 2; ++b)
#pragma unroll
                for (int m = 0; m < 4; ++m)
#pragma unroll
                    for (int n = 0; n < 2; ++n) acc[a][b][m][n] = (f32x4){0.f, 0.f, 0.f, 0.f};
        cur = nxt; cA = nA; cB = nB; ++ui;
        if (wr == 1) PG8_BAR;
    }
    PG8_WAIT_V(0);
    PG8_BAR;
#undef PG8_SA
#undef PG8_SB
#undef PG8_STAGE
#undef PG8_LDA
#undef PG8_LDB
#undef PG8_MMA
#undef PG8_WAIT_V
#undef PG8_WAIT_L
#undef PG8_BAR
#undef PG8_SCHED
}
}

namespace att {
constexpr int R = 288;
constexpr int K_OFF = 0, K_BYTES = 8 * R * 16, V_OFF = K_BYTES, V_BYTES = 2 * R * 64, TB_OFF = V_OFF + V_BYTES, TOTAL = TB_OFF + 4 * 256 * 4;
static_assert(TOTAL <= RING_BYTES, "attention LDS");
__device__ __forceinline__ s16x4 vtr(const LAS unsigned char* p) { return __builtin_amdgcn_ds_read_tr16_b64_v4i16((LAS s16x4*)p); }

template <int NT, bool META>
__device__ __forceinline__ void group(const LAS unsigned char* lds, const bf16_t* qkv, bf16_t* o, float sink2, int b, int kvh, int nblk, int g, int qs, int lane) {
    const int q = lane & 31, hi = lane >> 5, hq = 4 * kvh + g;
    int row; if (META) row = MR + (q < NMETA ? q : NMETA - 1); else row = b * S + nblk * 128 + 32 * qs + q;
    bf16x8 qf[4];
#pragma unroll
    for (int ds = 0; ds < 4; ++ds) qf[ds] = *(const bf16x8*)(qkv + (size_t)row * NQKV + hq * 64 + 16 * ds + 8 * hi);
    f32x16 sc[NT];
#pragma unroll
    for (int ti = 0; ti < NT; ++ti) {
        const int rb = ti == 0 ? 0 : 32 * (qs + ti);
        f32x16 a = {};
#pragma unroll
        for (int ds = 0; ds < 4; ++ds) { const bf16x8 kf = *(const LAS bf16x8*)(lds + K_OFF + (2 * ds + hi) * (R * 16) + (rb + q) * 16); a = __builtin_amdgcn_mfma_f32_32x32x16_bf16(kf, qf[ds], a, 0, 0, 0); }
        sc[ti] = a;
    }
    const LAS float* tb = (const LAS float*)(lds + TB_OFF) + g * 256;
    float mx = sink2;
    int base[16];
#pragma unroll
    for (int r = 0; r < 16; ++r) base[r] = (r & 3) + 8 * (r >> 2) + 4 * hi - q;
#pragma unroll
    for (int ti = 0; ti < NT; ++ti) {
        if (ti == 0) {
#pragma unroll
            for (int r = 0; r < 16; ++r) {
                float v = -1e30f;
                if (r < 8) {
                    const int kk = (r & 3) + 8 * (r >> 2) + 4 * hi;
                    if (META) { v = kk <= q ? sc[0][r] + tb[(q - kk) & 255] : -1e30f; }
                    else { int dist = NMETA + nblk * 128 + 32 * qs + q - kk; dist = dist > 255 ? 255 : dist; v = sc[0][r] + tb[dist]; }
                }
                sc[0][r] = v; mx = fmaxf(mx, v);
            }
        } else {
            const bool tile_ok = nblk > 0 || qs + ti - 1 >= 4;
#pragma unroll
            for (int r = 0; r < 16; ++r) {
                const float bias = tb[128 - 32 * (ti - 1) - base[r]];
                bool valid = tile_ok;
                if (ti == 1) valid = valid && base[r] >= 1;
                if (ti == 5) valid = valid && base[r] <= 0;
                const float v = valid ? sc[ti][r] + bias : -1e30f; sc[ti][r] = v; mx = fmaxf(mx, v);
            }
        }
    }
    mx = fmaxf(mx, __shfl_xor(mx, 32));
    float ls = 0.f;
#pragma unroll
    for (int ti = 0; ti < NT; ++ti)
#pragma unroll
        for (int r = 0; r < 16; ++r) { const float p = __builtin_amdgcn_exp2f(sc[ti][r] - mx); sc[ti][r] = p; ls += p; }
    ls += __shfl_xor(ls, 32); ls += __builtin_amdgcn_exp2f(sink2 - mx);
    f32x16 oT[2]; oT[0] = f32x16{}; oT[1] = f32x16{};
#pragma unroll
    for (int ti = 0; ti < NT; ++ti) {
        const int rb = ti == 0 ? 0 : 32 * (qs + ti);
#pragma unroll
        for (int s = 0; s < 2; ++s) {
            u32x4 pw; pw.x = cvtpk(sc[ti][8 * s + 0], sc[ti][8 * s + 1]); pw.y = cvtpk(sc[ti][8 * s + 2], sc[ti][8 * s + 3]); pw.z = cvtpk(sc[ti][8 * s + 4], sc[ti][8 * s + 5]); pw.w = cvtpk(sc[ti][8 * s + 6], sc[ti][8 * s + 7]);
            const bf16x8 pf = __builtin_bit_cast(bf16x8, pw);
#pragma unroll
            for (int dt = 0; dt < 2; ++dt) {
                const LAS unsigned char* vp = lds + V_OFF + dt * (R * 64) + (rb + 16 * s + 4 * hi + ((lane & 15) >> 2)) * 64 + ((lane >> 4) & 1) * 32 + (lane & 3) * 8;
                const s16x4 lo = vtr(vp), h4 = vtr(vp + 512);
                const bf16x8 vf = (bf16x8){lo[0], lo[1], lo[2], lo[3], h4[0], h4[1], h4[2], h4[3]};
                oT[dt] = __builtin_amdgcn_mfma_f32_32x32x16_bf16(vf, pf, oT[dt], 0, 0, 0);
            }
        }
    }
    const float inv = 1.0f / ls;
    if (!META || q < NMETA) {
#pragma unroll
        for (int dt = 0; dt < 2; ++dt)
#pragma unroll
            for (int rg = 0; rg < 4; ++rg) {
                u32x2 w; w.x = cvtpk(oT[dt][4 * rg + 0] * inv, oT[dt][4 * rg + 1] * inv); w.y = cvtpk(oT[dt][4 * rg + 2] * inv, oT[dt][4 * rg + 3] * inv);
                *(u32x2*)(o + (size_t)row * D + hq * 64 + 32 * dt + 8 * rg + 4 * hi) = w;
            }
    }
}

__device__ __forceinline__ void unit(LAS unsigned char* lds, const bf16_t* qkv, bf16_t* o, const float* TBg, const float* sinks, int b, int kvh, int nblk, int tid) {
    asm volatile("" : "+v"(tid));
    const int lane = tid & 63, wid = __builtin_amdgcn_readfirstlane(tid >> 6);
#pragma unroll
    for (int i = 0; i < 9; ++i) {
        const int task = tid + NTHR * i, isv = task >= 8 * R ? 1 : 0, rem = task - isv * 8 * R, row = rem >> 3, ch = rem & 7;
        int grow = -1;
        if (row < 32) { if (row < NMETA) grow = MR + row; }
        else { const int jk = row - 32; if (nblk < 64 && (nblk > 0 || jk >= 128)) grow = b * S + (nblk - 1) * 128 + jk; }
        u32x4 v = *(const u32x4*)(qkv + (size_t)(grow >= 0 ? grow : MR) * NQKV + 1024 + isv * 256 + kvh * 64 + ch * 8);
        if (grow < 0) v = (u32x4){0u, 0u, 0u, 0u};
        const int dst = isv ? V_OFF + (ch >> 2) * (R * 64) + row * 64 + (ch & 3) * 16 : K_OFF + ch * (R * 16) + row * 16;
        *(LAS u32x4*)(lds + dst) = v;
    }
    { LAS float* tb = (LAS float*)(lds + TB_OFF); tb[tid] = TBg[(size_t)(4 * kvh) * 256 + tid]; tb[tid + 512] = TBg[(size_t)(4 * kvh) * 256 + tid + 512]; }
    __syncthreads();
    const int g = wid >> 1;
    const float sink2 = sinks[4 * kvh + g] * LOG2E;
    if (nblk < 64) {
#pragma unroll 1
        for (int i = 0; i < 2; ++i) group<6, false>(lds, qkv, o, sink2, b, kvh, nblk, g, 2 * (wid & 1) + i, lane);
    } else if ((wid & 1) == 0) {
        group<1, true>(lds, qkv, o, sink2, b, kvh, nblk, g, 0, lane);
    }
    __syncthreads();
}
}

namespace meta {
__device__ __forceinline__ bf16_t tobf(float v) { return (bf16_t)(cvtpk(v, 0.f) & 0xffffu); }
__device__ __forceinline__ void rstd4(const float* ssqm, int lane, float (&rs)[4]) {
    const f32x4* p = (const f32x4*)(ssqm + (lane & 15) * 64 + (lane >> 4) * 16);
    const f32x4 a = p[0], b = p[1], c = p[2], d = p[3];
    float s = ((a[0] + a[1]) + (a[2] + a[3])) + ((b[0] + b[1]) + (b[2] + b[3])) + ((c[0] + c[1]) + (c[2] + c[3])) + ((d[0] + d[1]) + (d[2] + d[3]));
    s += __shfl_xor(s, 16); s += __shfl_xor(s, 32);
    const float r = __builtin_amdgcn_rsqf(s * (1.0f / D) + EPS);
#pragma unroll
    for (int reg = 0; reg < 4; ++reg) rs[reg] = __shfl(r, 4 * (lane >> 4) + reg);
}
template <int NBF>
__device__ __forceinline__ void mma16(const bf16_t* A, int lda, const bf16_t* B0, const bf16_t* B1, int ldb, int K, f32x4& c0, f32x4& c1, int lane) {
    const int r = lane & 15, kq = lane >> 4;
    const bf16_t* ap = A + (size_t)r * lda + 8 * kq; const bf16_t* bp0 = B0 + (size_t)r * ldb + 8 * kq; const bf16_t* bp1 = B1 + (size_t)r * ldb + 8 * kq;
    for (int k = 0; k < K; k += 256) {
        bf16x8 a[8], b0[8], b1[8];
#pragma unroll
        for (int u = 0; u < 8; ++u) { a[u] = *(const bf16x8*)(ap + k + 32 * u); b0[u] = *(const bf16x8*)(bp0 + k + 32 * u); if (NBF == 2) b1[u] = *(const bf16x8*)(bp1 + k + 32 * u); }
#pragma unroll
        for (int u = 0; u < 8; ++u) { c0 = __builtin_amdgcn_mfma_f32_16x16x32_bf16(a[u], b0[u], c0, 0, 0, 0); if (NBF == 2) c1 = __builtin_amdgcn_mfma_f32_16x16x32_bf16(a[u], b1[u], c1, 0, 0, 0); }
    }
}
__device__ __forceinline__ void task_qkv(int task, const bf16_t* HB, const bf16_t* Wt, const float* bias, const float* ssqm, bf16_t* qkv, int lane) {
    const int n0 = 16 * task; f32x4 c0 = {0.f, 0.f, 0.f, 0.f}, c1 = c0;
    mma16<1>(HB + (size_t)MR * D, D, Wt + (size_t)n0 * D, Wt, D, D, c0, c1, lane);
    float rs[4]; rstd4(ssqm, lane, rs);
    const int n = n0 + (lane & 15); const float bv = bias[n], sc = n0 < 1024 ? QSCALE : 1.0f;
#pragma unroll
    for (int reg = 0; reg < 4; ++reg) { const int row = 4 * (lane >> 4) + reg; qkv[(size_t)(MR + row) * NQKV + n] = tobf((c0[reg] * rs[reg] + bv) * sc); }
}
__device__ __forceinline__ void task_gu(int task, const bf16_t* HB, const bf16_t* Wgu, const float* ssqm, bf16_t* act, int lane) {
    const int c = 16 * task; f32x4 c0 = {0.f, 0.f, 0.f, 0.f}, c1 = c0;
    const bf16_t* B0 = Wgu + (size_t)(256 * (c >> 7) + (c & 127)) * D;
    mma16<2>(HB + (size_t)MR * D, D, B0, B0 + (size_t)128 * D, D, D, c0, c1, lane);
    float rs[4]; rstd4(ssqm, lane, rs);
#pragma unroll
    for (int reg = 0; reg < 4; ++reg) { const int row = 4 * (lane >> 4) + reg; act[(size_t)(MR + row) * FF + c + (lane & 15)] = tobf(pg8::silu_mul(c0[reg] * rs[reg], c1[reg] * rs[reg])); }
}
__device__ __forceinline__ void task_cin(int task, const bf16_t* HB, const bf16_t* Wcin, const float* ssqm, bf16_t* GB, bf16_t* Z, int lane) {
    f32x4 c0 = {0.f, 0.f, 0.f, 0.f}, c1 = c0; float rs[4];
    if (task < 64) {
        const int n0 = 16 * task;
        mma16<1>(HB + (size_t)MR * D, D, Wcin + (size_t)n0 * D, Wcin, D, D, c0, c1, lane);
        rstd4(ssqm, lane, rs);
#pragma unroll
        for (int reg = 0; reg < 4; ++reg) { const int row = 4 * (lane >> 4) + reg; GB[(size_t)(MR + row) * D + n0 + (lane & 15)] = tobf(c0[reg] * rs[reg]); }
    } else {
        const int c = 16 * (task - 64);
        const bf16_t* B0 = Wcin + (size_t)(1024 + 256 * (c >> 7) + (c & 127)) * D;
        mma16<2>(HB + (size_t)MR * D, D, B0, B0 + (size_t)128 * D, D, D, c0, c1, lane);
        rstd4(ssqm, lane, rs);
#pragma unroll
        for (int reg = 0; reg < 4; ++reg) { const int row = 4 * (lane >> 4) + reg; Z[(size_t)(MR + row) * D + c + (lane & 15)] = tobf(c0[reg] * c1[reg] * rs[reg] * rs[reg]); }
    }
}
__device__ __forceinline__ void task_res(int task, const bf16_t* A, int lda, int a_pn_off, const bf16_t* Wt, int ldb, int K, const float* bias, const float* cscale, float* hmeta, bf16_t* HB, float* ssqm, int lane) {
    const int n0 = 16 * task; f32x4 c0 = {0.f, 0.f, 0.f, 0.f}, c1 = c0;
    mma16<1>(A + (size_t)MR * lda + (size_t)(n0 >> 8) * a_pn_off, lda, Wt + (size_t)n0 * ldb, Wt, ldb, K, c0, c1, lane);
    const int n = n0 + (lane & 15); const float bv = bias ? bias[n] : 0.f, cs = cscale ? cscale[n] : 1.0f;
#pragma unroll
    for (int reg = 0; reg < 4; ++reg) {
        const int row = 4 * (lane >> 4) + reg;
        const float v = hmeta[(size_t)row * D + n] + (c0[reg] + bv) * cs;
        hmeta[(size_t)row * D + n] = v; HB[(size_t)(MR + row) * D + n] = tobf(v);
        float q = v * v; q += __shfl_xor(q, 1); q += __shfl_xor(q, 2); q += __shfl_xor(q, 4); q += __shfl_xor(q, 8);
        if ((lane & 15) == 0) ssqm[row * 64 + task] = q;
    }
}
}

namespace pool {
constexpr int RSL_OFF = MISC_OFF + 128;
static_assert(RSL_OFF + 79 * 4 <= LDS_BYTES, "pool LDS");
__device__ __forceinline__ int mix_off(int row, int ch  ) { return row * 2048 + ((ch ^ (row & 7)) << 4); }

template <int WIN>
__device__ __forceinline__ void mix_rows(LAS unsigned char* lds, const bf16_t* HB, const float* gmix, int b, int t0, int nrows, bool mq, int tid) {
    const LAS float* rsl = (const LAS float*)(lds + RSL_OFF);
    const int c = 2 * tid;
    const f32x2 gg = *(const f32x2*)(gmix + c);
    unsigned hv[79];
#pragma unroll
    for (int p = 16 - WIN; p < 79; ++p) {
        int t = t0 - 15 + p; t = t < 0 ? 0 : (t > t0 + nrows - 1 ? t0 + nrows - 1 : t);
        const int row = t < NMETA ? MR + t : b * S + (t - NMETA); hv[p] = *(const unsigned*)(HB + (size_t)row * D + c);
    }
#define POOL_AV(p) ((f32x2){__builtin_bit_cast(float, hv[p] << 16), __builtin_bit_cast(float, hv[p] & 0xffff0000u)} * rsl[p] * gg)
    f32x2 Ssum = (f32x2){0.f, 0.f};
#pragma unroll
    for (int p = 16 - WIN; p < 15; ++p) Ssum += POOL_AV(p);
#pragma unroll
    for (int i = 0; i < 64; ++i) {
        const int p = 15 + i; const f32x2 at = POOL_AV(p); Ssum += at;
        const int tt = t0 + i; const float ic = (tt + 1 >= WIN) ? (1.0f / WIN) : __builtin_amdgcn_rcpf((float)(tt + 1));
        const f32x2 mx = Ssum * ic - at;
        *(LAS unsigned*)(lds + mix_off(i, tid >> 2) + (tid & 3) * 4) = cvtpk(mx[0], mx[1]);
        Ssum -= POOL_AV(p - WIN + 1);
    }
#undef POOL_AV
    (void)mq;
}

__device__ __forceinline__ void unit(LAS unsigned char* lds, const bf16_t* HB, bf16_t* HBo, float* hmeta, const float* ssq, float* ssqo, float* ssqm, int rmask, const bf16_t* Wp, const float* gmix, const float* scale, int b, int t0, bool mq, int tid) {
    asm volatile("" : "+v"(tid));
    const int lane = tid & 63, w = __builtin_amdgcn_readfirstlane(tid >> 6);
    const int nrows = mq ? NMETA : 64, nrt = mq ? 1 : 4;
    LAS float* rsl = (LAS float*)(lds + RSL_OFF);
    __syncthreads();
    if (tid < 79) { const int t = t0 - 15 + tid; float rs = 0.f;
        if (t >= 0 && t < t0 + nrows) { float s = 0.f;
            if (t >= NMETA) { const f32x4* p = (const f32x4*)(ssq + (size_t)(b * S + t - NMETA) * 16);
#pragma unroll
                for (int k = 0; k < 4; ++k) { const f32x4 a = p[k]; s += (a[0] + a[1]) + (a[2] + a[3]); } }
            else { const f32x4* p = (const f32x4*)(ssqm + (size_t)t * 64);
#pragma unroll
                for (int k = 0; k < 16; ++k) { const f32x4 a = p[k]; s += (a[0] + a[1]) + (a[2] + a[3]); } }
            rs = 1.0f / sqrtf(s * (1.0f / D) + EPS); }
        rsl[tid] = rs; }
    __syncthreads();
    const int grp = w >> 1;
    if (grp == 0) mix_rows<2>(lds, HB, gmix, b, t0, nrows, mq, tid);
    else if (grp == 1) mix_rows<4>(lds, HB, gmix, b, t0, nrows, mq, tid);
    else if (grp == 2) mix_rows<8>(lds, HB, gmix, b, t0, nrows, mq, tid);
    else mix_rows<16>(lds, HB, gmix, b, t0, nrows, mq, tid);
    __syncthreads();
    const int g = w >> 1, nbase = 256 * g + 128 * (w & 1);
    const int tr = lane & 15, kq = lane >> 4;
    const bf16_t* wrow = Wp + (size_t)(nbase + tr) * 256 + 8 * kq;
    const size_t grow0 = mq ? (size_t)MR : (size_t)b * S + (t0 - NMETA);
    float q[4] = {0.f, 0.f, 0.f, 0.f};
    bf16x8 b0[8], b1[8];
#define POOL_LOADB(dst, ct) do { _Pragma("unroll") for (int ks = 0; ks < 8; ++ks) dst[ks] = *(const bf16x8*)(wrow + (size_t)(ct) * 16 * 256 + ks * 32); } while (0)
#define POOL_COMPUTE(bf, ct) do { \
        const int n0 = nbase + 16 * (ct) + 4 * kq; \
        const f32x4 sc4 = *(const f32x4*)(scale + n0); \
        u32x2 hbv[4]; \
        _Pragma("unroll") for (int rt = 0; rt < 4; ++rt) if (rt < nrt) hbv[rt] = *(const u32x2*)(HB + (grow0 + 16 * rt + tr) * D + n0); \
        _Pragma("unroll") for (int rt = 0; rt < 4; ++rt) if (rt < nrt) { \
            f32x4 acc = {0.f, 0.f, 0.f, 0.f}; const int row = 16 * rt + tr; \
            _Pragma("unroll") for (int ks = 0; ks < 8; ++ks) { const bf16x8 af = *(const LAS bf16x8*)(lds + mix_off(row, 32 * g + 4 * ks + kq)); acc = __builtin_amdgcn_mfma_f32_16x16x32_bf16(bf[ks], af, acc, 0, 0, 0); } \
            const u32x2 hb = hbv[rt]; \
            const f32x4 h4 = (f32x4){__builtin_bit_cast(float, hb.x << 16), __builtin_bit_cast(float, hb.x & 0xffff0000u), __builtin_bit_cast(float, hb.y << 16), __builtin_bit_cast(float, hb.y & 0xffff0000u)}; \
            const f32x4 v = h4 + acc * sc4; \
            u32x2 o; o.x = cvtpk(v[0], v[1]); o.y = cvtpk(v[2], v[3]); \
            *(u32x2*)(HBo + ((grow0 + row) & (size_t)(long)rmask) * D + n0) = o; \
            if (mq && rmask == -1) *(f32x4*)(hmeta + (size_t)row * D + n0) = v; \
            q[rt] += (v[0] * v[0] + v[1] * v[1]) + (v[2] * v[2] + v[3] * v[3]); } } while (0)
    POOL_LOADB(b0, 0);
#pragma unroll 1
    for (int ct = 0; ct < 8; ct += 2) {
        POOL_LOADB(b1, ct + 1);
        POOL_COMPUTE(b0, ct);
        if (ct + 2 < 8) POOL_LOADB(b0, ct + 2);
        POOL_COMPUTE(b1, ct + 1);
    }
#undef POOL_LOADB
#undef POOL_COMPUTE
#pragma unroll
    for (int rt = 0; rt < 4; ++rt) if (rt < nrt) {
        float s = q[rt]; s += __shfl_xor(s, 16); s += __shfl_xor(s, 32);
        if (lane < 16) {
            const int row = 16 * rt + lane;
            if (!mq) { float* p = ssqo + ((grow0 + row) & (size_t)(long)rmask) * 16; p[w] = s; p[8 + w] = 0.f; }
            else if (rmask == -1) { float* p = ssqm + (size_t)row * 64; p[w] = s;
#pragma unroll
                for (int k = 1; k < 8; ++k) p[8 * k + w] = 0.f; }
        }
    }
}
}

#define XB_TMO      128
#define XB_XCNT(j)  (256  + 64 * (j))
#define XB_XSUB(j)  (1280 + 64 * (j))
#define XB_XGEN(j)  (2304 + 64 * (j))
#define XB_TOP      3328
#define XB_TOPGEN   3392
#define XCD_BAR_WORDS 3456
#define XB_SPIN_CAP (1u << 18)
__device__ __forceinline__ unsigned xb_ld(unsigned* p)              { return __hip_atomic_load(p, __ATOMIC_RELAXED, __HIP_MEMORY_SCOPE_AGENT); }
__device__ __forceinline__ unsigned xb_add(unsigned* p, unsigned v) { return __hip_atomic_fetch_add(p, v, __ATOMIC_RELAXED, __HIP_MEMORY_SCOPE_AGENT); }
__device__ __forceinline__ unsigned xb_xcc_id() { return (unsigned)__builtin_amdgcn_s_getreg((3 << 11) | 20) & 0xFu; }
#define XB_SPIN(cond, bar) do { unsigned _sp = 0; while (cond) { __builtin_amdgcn_s_sleep(1); \
    if ((++_sp & 255u) == 0u) { if (xb_ld(&(bar)[XB_TMO])) break; if (_sp > XB_SPIN_CAP) { atomicAdd(&(bar)[XB_TMO], 1u); break; } } } } while (0)
struct XcdBarrier { unsigned* bar; unsigned x; volatile LAS unsigned* st; };
__device__ __forceinline__ XcdBarrier xcd_barrier_post(unsigned* bar, volatile LAS unsigned* st) {
    XcdBarrier b; b.bar = bar; b.x = xb_xcc_id(); b.st = st;
    if (threadIdx.x == 0) (void)xb_add(&bar[XB_XCNT(b.x)], 1u);
    return b;
}
__device__ __forceinline__ void xcd_barrier_complete(unsigned* bar, unsigned x, unsigned& nloc, unsigned& nx) {
    const unsigned G = gridDim.x * gridDim.y * gridDim.z;
    unsigned sum, cnt, mine, sp = 0u;
    for (;;) {
        sum = 0u; cnt = 0u; mine = 0u;
#pragma unroll
        for (unsigned j = 0; j < 16; ++j) { const unsigned c = xb_ld(&bar[XB_XCNT(j)]); sum += c; cnt += (c > 0u) ? 1u : 0u; mine = (j == x) ? c : mine; }
        if (sum == G) break;
        __builtin_amdgcn_s_sleep(1);
        if ((++sp & 255u) == 0u) { if (xb_ld(&bar[XB_TMO])) break; if (sp > XB_SPIN_CAP) { atomicAdd(&bar[XB_TMO], 1u); break; } }
    }
    nloc = mine > 0u ? mine : 1u; nx = cnt > 0u ? cnt : 1u;
}
__device__ __forceinline__ void xcd_barrier(const XcdBarrier& b) {
    asm volatile("s_waitcnt vmcnt(0)" ::: "memory");
    __syncthreads();
    if (threadIdx.x == 0) {
        unsigned* bar = b.bar;
        __builtin_amdgcn_s_waitcnt(0);
        unsigned nloc = b.st[0], nx = b.st[1];
        if (nloc == 0u) { xcd_barrier_complete(bar, b.x, nloc, nx); b.st[0] = nloc; b.st[1] = nx; }
        const unsigned old = xb_add(&bar[XB_XSUB(b.x)], 1u);
        const unsigned gen = old / nloc;
        if (old + 1u == (gen + 1u) * nloc) {
            __builtin_amdgcn_fence(__ATOMIC_RELEASE, "agent");
            asm volatile("s_waitcnt vmcnt(0)" ::: "memory");
            const unsigned og = xb_add(&bar[XB_TOP], 1u);
            const unsigned tg = og / nx;
            if (og + 1u == (tg + 1u) * nx) xb_add(&bar[XB_TOPGEN], 1u);
            else XB_SPIN(xb_ld(&bar[XB_TOPGEN]) == tg, bar);
            __builtin_amdgcn_fence(__ATOMIC_ACQUIRE, "agent");
            xb_add(&bar[XB_XGEN(b.x)], 1u);
            asm volatile("s_waitcnt vmcnt(0)" ::: "memory");
        } else {
            XB_SPIN(xb_ld(&bar[XB_XGEN(b.x)]) == gen, bar);
            __builtin_amdgcn_fence(__ATOMIC_ACQUIRE, "agent");
            asm volatile("s_waitcnt vmcnt(0)" ::: "memory");
        }
    }
    __syncthreads();
}

struct Args { const float* in[19]; float* out; unsigned char* ws; int ph_lo, ph_hi; };
constexpr int N_PHASES = 20;

constexpr int I_ATT = 768 + 512, I_CONV = 1536 + 512, I_POOL = 128, I_FFN = 3 * 1408, NITEMS = 2 * I_ATT + I_CONV + I_POOL + 4 * I_FFN;
struct CvItem { const float* src; bf16_t* dst; const float* gain; int N, ldt; };
__device__ __forceinline__ CvItem cv_decode(int it, const Args& args, unsigned char* wts) {
    const float* norm_mix = args.in[3]; const float* norm_ffn = args.in[4];
    CvItem c; int r = it;
    if (r < 2 * I_ATT) {
        const int j = r / I_ATT; r -= j * I_ATT; unsigned char* wl = wts + j * W_ATT_STRIDE;
        if (r < 768) { const int kb = r / 48, nb = r % 48; c.src = args.in[6] + (size_t)j * D * NQKV + (size_t)(64 * kb) * NQKV + 32 * nb; c.N = NQKV; c.dst = (bf16_t*)(wl + W_QKV) + (size_t)(32 * nb) * D + 64 * kb; c.ldt = D; c.gain = norm_mix + (size_t)(3 * j) * D + 64 * kb; }
        else { r -= 768; const int kb = r / 32, nb = r % 32; c.src = args.in[8] + (size_t)j * D * D + (size_t)(64 * kb) * D + 32 * nb; c.N = D; c.dst = (bf16_t*)(wl + W_O) + (size_t)(32 * nb) * D + 64 * kb; c.ldt = D; c.gain = nullptr; }
        return c;
    }
    r -= 2 * I_ATT;
    if (r < I_CONV) {
        if (r < 1536) { const int kb = r / 96, nb = r % 96, n0 = 32 * nb; int drow;
            if (n0 < 1024) drow = n0; else { const int cc = (n0 - 1024) & 1023, isu = n0 >= 2048 ? 1 : 0; drow = 1024 + 256 * (cc >> 7) + 128 * isu + (cc & 127); }
            c.src = args.in[11] + (size_t)(64 * kb) * (3 * D) + n0; c.N = 3 * D; c.dst = (bf16_t*)(wts + W_CIN) + (size_t)drow * D + 64 * kb; c.ldt = D; c.gain = norm_mix + (size_t)1 * D + 64 * kb; }
        else { r -= 1536; const int kb = r / 32, nb = r % 32; c.src = args.in[13] + (size_t)(64 * kb) * D + 32 * nb; c.N = D; c.dst = (bf16_t*)(wts + W_COUT) + (size_t)(32 * nb) * D + 64 * kb; c.ldt = D; c.gain = nullptr; }
        return c;
    }
    r -= I_CONV;
    if (r < I_POOL) { const int gi = r / 32; r -= gi * 32; const int kb = r / 8, nb = r % 8;
        c.src = args.in[14] + (size_t)gi * 256 * 256 + (size_t)(64 * kb) * 256 + 32 * nb; c.N = 256; c.dst = (bf16_t*)(wts + W_POOL) + (size_t)(gi * 256 + 32 * nb) * 256 + 64 * kb; c.ldt = 256; c.gain = nullptr; return c; }
    r -= I_POOL;
    { const int i = r / I_FFN; r -= i * I_FFN; unsigned char* wl = wts + W_FFN + i * W_FFN_STRIDE;
      if (r < 2816) { const int isu = r >= 1408 ? 1 : 0; r -= isu * 1408; const int kb = r / 88, nb = r % 88, n0 = 32 * nb;
          c.src = args.in[16 + isu] + (size_t)i * D * FF + (size_t)(64 * kb) * FF + n0; c.N = FF; c.dst = (bf16_t*)(wl + W_GU) + (size_t)(256 * (n0 >> 7) + 128 * isu + (n0 & 127)) * D + 64 * kb; c.ldt = D; c.gain = norm_ffn + (size_t)i * D + 64 * kb; }
      else { r -= 2816; const int kb = r / 32, nb = r % 32; c.src = args.in[18] + (size_t)i * FF * D + (size_t)(64 * kb) * D + 32 * nb; c.N = D; c.dst = (bf16_t*)(wl + W_DN) + (size_t)(32 * nb) * FF + 64 * kb; c.ldt = FF; c.gain = nullptr; } }
    return c;
}
__device__ __forceinline__ void cv_load(const CvItem& c, float (&w)[32], int lane) {
#pragma unroll
    for (int i = 0; i < 32; ++i) w[i] = c.src[(size_t)(2 * i + (lane >> 5)) * c.N + (lane & 31)];
}
__device__ __forceinline__ void cv_store(const CvItem& c, const float (&w)[32], LAS float* scr, int lane) {
    const int ch = lane & 7;
    f32x4 g0 = {1.f, 1.f, 1.f, 1.f}, g1 = g0;
    if (c.gain) { g0 = *(const f32x4*)(c.gain + 8 * ch); g1 = *(const f32x4*)(c.gain + 8 * ch + 4); }
#pragma unroll
    for (int i = 0; i < 32; ++i) scr[(2 * i + (lane >> 5)) * 33 + (lane & 31)] = w[i];
    LDS_WAIT(); asm volatile("" ::: "memory");
#pragma unroll
    for (int j = 0; j < 4; ++j) { const int n = (lane >> 3) + 8 * j; const LAS float* sp = scr + (8 * ch) * 33 + n;
        u32x4 o; o.x = cvtpk(sp[0 * 33] * g0[0], sp[1 * 33] * g0[1]); o.y = cvtpk(sp[2 * 33] * g0[2], sp[3 * 33] * g0[3]); o.z = cvtpk(sp[4 * 33] * g1[0], sp[5 * 33] * g1[1]); o.w = cvtpk(sp[6 * 33] * g1[2], sp[7 * 33] * g1[3]);
        *(u32x4*)(c.dst + (size_t)n * c.ldt + 8 * ch) = o; }
    LDS_WAIT(); asm volatile("" ::: "memory");
}
template <int NI>
__device__ __forceinline__ void cv_run(const Args& args, unsigned char* wts, int a1, int n1, int a2, int n2, int cw, int NCW, LAS float* scr, int lane) {
    const int total = n1 + n2;
    for (int base = cw; base < total; base += NCW * NI) {
        CvItem it[NI]; float w[NI][32]; bool ok[NI];
#pragma unroll
        for (int k = 0; k < NI; ++k) { const int idx = base + NCW * k; ok[k] = idx < total; const int id = ok[k] ? idx : base; it[k] = cv_decode(id < n1 ? a1 + id : a2 + (id - n1), args, wts); if (ok[k]) cv_load(it[k], w[k], lane); }
#pragma unroll
        for (int k = 0; k < NI; ++k) if (ok[k]) cv_store(it[k], w[k], scr, lane);
    }
}


__global__ void __launch_bounds__(NTHR, 2) mega_fwd(Args args) {
    extern __shared__ __attribute__((aligned(16))) unsigned char lds_raw[];
    LAS unsigned char* lds = (LAS unsigned char*)lds_raw;
    const int G = gridDim.x, bx = blockIdx.x;
    const int vcu = (G % 8 == 0) ? (bx % 8) * (G / 8) + bx / 8 : bx;
    for (int u = threadIdx.x; u < (LDS_BYTES - LDSCTL_OFF) / 4; u += NTHR) ((LAS unsigned*)(lds + LDSCTL_OFF))[u] = 0u;
    __syncthreads();
    XcdBarrier bar; bar.bar = (unsigned*)(args.ws + WS_CTL) + CW_BAR; bar.x = 0; bar.st = nullptr;
    if (MK_N_LAUNCHES == 1) bar = xcd_barrier_post((unsigned*)(args.ws + WS_CTL) + CW_BAR, (volatile LAS unsigned*)(lds + MISC_OFF) + 8);

#define IDS() int tid = threadIdx.x; asm volatile("" : "+v"(tid)); const int lane = tid & 63, wave = __builtin_amdgcn_readfirstlane(tid >> 6); \
    const int gw = vcu * NWAVES + wave, NGW = G * NWAVES, gtid = vcu * NTHR + tid, NGT = G * NTHR, mw = (G - 1 - bx) * NWAVES + wave; \
    (void)lane; (void)gw; (void)NGW; (void)gtid; (void)NGT; (void)mw

    for (int ph = args.ph_lo; ph < args.ph_hi; ++ph) {
        unsigned long long zoff = 0; asm volatile("" : "+s"(zoff));
        unsigned char* ws = args.ws + zoff;
        const float* x = args.in[0]; const float* meta_tok = args.in[1]; const float* rel_table = args.in[2];
        const float* norm_mix = args.in[3]; const float* norm_ffn = args.in[4]; const float* norm_final = args.in[5];
        const float* bqkv = args.in[7]; const float* bo = args.in[9]; const float* sinks = args.in[10];
        const float* conv_w = args.in[12]; const float* pool_scale = args.in[15];
        float* dout = args.out;
        float* hmeta = (float*)(ws + WS_HMETA); float* ssq = (float*)(ws + WS_SSQ); float* ssqm = (float*)(ws + WS_SSQM); float* TB = (float*)(ws + WS_TB);
        bf16_t* HB = (bf16_t*)(ws + (ph >= 12 ? WS_HB2 : WS_HB)); unsigned char* wts = ws + WS_W; unsigned char* big = ws + WS_BIG;
        const int nrep = ((PROBE_MASK >> ph) & 1u) ? 2 : 1;
        for (int prep = 0; prep < nrep; ++prep) {
        const bool dry = prep + 1 < nrep;
        bf16_t* r_hb = dry ? (bf16_t*)(ws + 250 * MiB) : HB; float* r_ssq = dry ? (float*)(ws + 252 * MiB) : ssq; const int r_mask = dry ? 1023 : -1;
        float* r_fout = ph == 18 ? (dry ? (float*)(ws + 246 * MiB) : dout) : nullptr;
        if (ph == 0) {
            IDS();
            LAS float* scr = (LAS float*)(lds + wave * 16384);
            cv_run<2>(args, wts, 0, I_ATT, 2 * I_ATT + I_CONV + I_POOL, I_FFN, gw, NGW, scr, lane);
            for (int i = gtid; i < NH * 256; i += NGT) { const int h = i >> 8, dist = i & 255; TB[i] = rel_table[bucket_of(dist) * NH + h] * LOG2E; }
            for (int r0 = gw * 4; r0 < MT; r0 += NGW * 4) {
                f32x4 v[4][4];
#pragma unroll
                for (int q = 0; q < 4; ++q) { const int r = r0 + q; const float* src = r < MR ? x + (size_t)r * D : meta_tok + (size_t)(r - MR) * D; const f32x4* xr = (const f32x4*)src + lane;
#pragma unroll
                    for (int j = 0; j < 4; ++j) v[q][j] = xr[64 * j]; }
#pragma unroll
                for (int q = 0; q < 4; ++q) { const int r = r0 + q; float s = 0.f;
#pragma unroll
                    for (int j = 0; j < 4; ++j) s += (v[q][j][0] * v[q][j][0] + v[q][j][1] * v[q][j][1]) + (v[q][j][2] * v[q][j][2] + v[q][j][3] * v[q][j][3]);
                    s = wave_sum(s);
                    u32x2* o8 = (u32x2*)(HB + (size_t)r * D) + lane;
#pragma unroll
                    for (int j = 0; j < 4; ++j) { u32x2 w; w.x = cvtpk(v[q][j][0], v[q][j][1]); w.y = cvtpk(v[q][j][2], v[q][j][3]); o8[64 * j] = w; }
                    if (r >= MR) { f32x4* hm = (f32x4*)(hmeta + (size_t)(r - MR) * D) + lane;
#pragma unroll
                        for (int j = 0; j < 4; ++j) hm[64 * j] = v[q][j]; }
                    if (r < MR) { if (lane < 16) ssq[(size_t)r * 16 + lane] = lane == 0 ? s : 0.f; } else ssqm[(r - MR) * 64 + lane] = lane == 0 ? s : 0.f; }
            }
        } else if (ph == 19) {
            IDS();
            for (int r0 = gw * 4; r0 < MR; r0 += NGW * 4) {
                f32x4 v[4][4]; float p[4];
#pragma unroll
                for (int q = 0; q < 4; ++q) { const int r = r0 + q; p[q] = lane < 16 ? ssq[(size_t)r * 16 + lane] : 0.f; const f32x4* xr = (const f32x4*)(dout + (size_t)r * D) + lane;
#pragma unroll
                    for (int j = 0; j < 4; ++j) v[q][j] = xr[64 * j]; }
                const f32x4* gr = (const f32x4*)norm_final + lane; f32x4 gg[4];
#pragma unroll
                for (int j = 0; j < 4; ++j) gg[j] = gr[64 * j];
#pragma unroll
                for (int q = 0; q < 4; ++q) { const float rs = 1.0f / sqrtf(wave_sum(p[q]) * (1.0f / D) + EPS); f32x4* xr = (f32x4*)(dout + (size_t)(r0 + q) * D) + lane;
#pragma unroll
                    for (int j = 0; j < 4; ++j) xr[64 * j] = v[q][j] * rs * gg[j]; }
            }
        } else {
            const int li = ph <= 5 ? 0 : (ph <= 10 ? 1 : (ph <= 13 ? 2 : 3));
            const int first = li == 0 ? 1 : (li == 1 ? 6 : (li == 2 ? 11 : 14));
            const int last = li == 0 ? 5 : (li == 1 ? 10 : (li == 2 ? 13 : 18));
            unsigned char* wffn = wts + W_FFN + li * W_FFN_STRIDE;
            if (ph == last - 1) {
                { IDS(); pg8::Gemm g{HB, (const bf16_t*)(wffn + W_GU), D, D, D, 0}; pg8::StaticOrder So; So.init(64, 22, G, bx);
                  pg8::EpiSwiGLU E{(bf16_t*)big, ssq};
                  pg8::gemm_phase<pg8::EpiSwiGLU>(lds, g, So, E, tid); }
                { IDS(); for (int task = mw; task < 176; task += NGW) meta::task_gu(task, HB, (const bf16_t*)(wffn + W_GU), ssqm, (bf16_t*)big, lane); }
                if (li < 3 && !dry && bx >= G / 2) {
                    IDS(); LAS float* scr = (LAS float*)(lds + wave * 16384);
                    const int a1 = li == 0 ? 2 * I_ATT : (li == 1 ? 2 * I_ATT + I_CONV : I_ATT), n1 = li == 0 ? 0 : (li == 1 ? I_POOL : I_ATT);
                    cv_run<4>(args, wts, a1, n1, 2 * I_ATT + I_CONV + I_POOL + (li + 1) * I_FFN, I_FFN, (bx - G / 2) * NWAVES + wave, (G - G / 2) * NWAVES, scr, lane);
                }
            } else if (ph == last) {
                { IDS(); pg8::Gemm g{(const bf16_t*)big, (const bf16_t*)(wffn + W_DN), FF, FF, FF, 0}; pg8::StaticOrder So; So.init(64, 4, G, bx);
                  pg8::EpiResid E{HB, r_hb, r_fout, r_ssq, nullptr, nullptr, r_mask};
                  pg8::gemm_phase<pg8::EpiResid>(lds, g, So, E, tid); }
                if (!dry) { IDS(); for (int task = mw; task < 64; task += NGW) meta::task_res(task, (const bf16_t*)big, FF, 0, (const bf16_t*)(wffn + W_DN), FF, FF, nullptr, nullptr, hmeta, HB, ssqm, lane); }
            } else if (li == 0 || li == 3) {
                const int j = li == 0 ? 0 : 1; unsigned char* wl = wts + j * W_ATT_STRIDE;
                bf16_t* qkv = (bf16_t*)(big + BIG_QKV); bf16_t* ob = (bf16_t*)(big + BIG_O);
                if (ph == first) {
                    { IDS(); pg8::Gemm g{HB, (const bf16_t*)(wl + W_QKV), D, D, D, 0}; pg8::StaticOrder So; So.init(64, 6, G, bx);
                      pg8::EpiQKV E{qkv, bqkv + (size_t)j * NQKV, ssq};
                      pg8::gemm_phase<pg8::EpiQKV>(lds, g, So, E, tid); }
                    { IDS(); for (int task = mw; task < 96; task += NGW) meta::task_qkv(task, HB, (const bf16_t*)(wl + W_QKV), bqkv + (size_t)j * NQKV, ssqm, qkv, lane); }
                    if (li == 0 && !dry && bx >= G / 2) {
                        IDS(); LAS float* scr = (LAS float*)(lds + wave * 16384);
                        cv_run<4>(args, wts, 2 * I_ATT, I_CONV, 0, 0, (bx - G / 2) * NWAVES + wave, (G - G / 2) * NWAVES, scr, lane);
                    }
                } else if (ph == first + 1) {
                    for (int ui = vcu; ui < NB * NKV * 64 + NKV; ui += G) {
                        const bool mq = ui >= NB * NKV * 64; const int nblk = mq ? 64 : (ui & 63), bk = mq ? (ui - NB * NKV * 64) : (ui >> 6);
                        att::unit(lds, qkv, ob, TB, sinks + (size_t)j * NH, bk >> 2, bk & 3, nblk, threadIdx.x);
                    }
                } else {
                    { IDS(); pg8::Gemm g{ob, (const bf16_t*)(wl + W_O), D, D, D, 0}; pg8::StaticOrder So; So.init(64, 4, G, bx);
                      pg8::EpiResid E{HB, r_hb, nullptr, r_ssq, bo + (size_t)j * D, nullptr, r_mask};
                      pg8::gemm_phase<pg8::EpiResid>(lds, g, So, E, tid); }
                    if (!dry) { IDS(); for (int task = mw; task < 64; task += NGW) meta::task_res(task, ob, D, 0, (const bf16_t*)(wl + W_O), D, D, bo + (size_t)j * D, nullptr, hmeta, HB, ssqm, lane); }
                }
            } else if (li == 1) {
                bf16_t* GBb = (bf16_t*)(big + BIG_GB); bf16_t* Zb = (bf16_t*)(big + BIG_Z); bf16_t* Gb = (bf16_t*)(big + BIG_G);
                if (ph == first) {
                    { IDS(); pg8::Gemm g{HB, (const bf16_t*)(wts + W_CIN), D, D, D, 0}; pg8::StaticOrder So; So.init(64, 12, G, bx);
                      pg8::EpiConvIn E{GBb, Zb, ssq};
                      pg8::gemm_phase<pg8::EpiConvIn>(lds, g, So, E, tid); }
                    { IDS(); for (int task = mw; task < 128; task += NGW) meta::task_cin(task, HB, (const bf16_t*)(wts + W_CIN), ssqm, GBb, Zb, lane); }
                } else if (ph == first + 1) {
                    IDS();
                    for (int it = gtid; it < MT * 128; it += NGT) {
                        const int r = it >> 7, c8 = (it & 127) * 8;
                        int r1, r2;
                        if (r < MR) { const int s = r & (S - 1); r1 = s >= 1 ? r - 1 : MR + 15; r2 = s >= 2 ? r - 2 : MR + 14 + s; }
                        else { const int m = (r - MR) & 15; r1 = m >= 1 ? r - 1 : -1; r2 = m >= 2 ? r - 2 : -1; }
                        const u32x4 z0 = *(const u32x4*)(Zb + (size_t)r * D + c8);
                        u32x4 z1 = *(const u32x4*)(Zb + (size_t)(r1 >= 0 ? r1 : r) * D + c8), z2 = *(const u32x4*)(Zb + (size_t)(r2 >= 0 ? r2 : r) * D + c8);
                        if (r1 < 0) z1 = (u32x4){0u, 0u, 0u, 0u};
                        if (r2 < 0) z2 = (u32x4){0u, 0u, 0u, 0u};
                        const u32x4 gb = *(const u32x4*)(GBb + (size_t)r * D + c8);
                        const float* w0 = conv_w + c8; const float* w1 = conv_w + D + c8; const float* w2 = conv_w + 2 * D + c8;
                        u32x4 ov;
#pragma unroll
                        for (int e = 0; e < 4; ++e) {
                            const unsigned a0 = z0[e], a1 = z1[e], a2 = z2[e], ag = gb[e];
                            const float lo = bf2f((unsigned short)(ag & 0xffffu)) * (w2[2 * e] * bf2f((unsigned short)(a0 & 0xffffu)) + w1[2 * e] * bf2f((unsigned short)(a1 & 0xffffu)) + w0[2 * e] * bf2f((unsigned short)(a2 & 0xffffu)));
                            const float hi = bf2f((unsigned short)(ag >> 16)) * (w2[2 * e + 1] * bf2f((unsigned short)(a0 >> 16)) + w1[2 * e + 1] * bf2f((unsigned short)(a1 >> 16)) + w0[2 * e + 1] * bf2f((unsigned short)(a2 >> 16)));
                            ov[e] = cvtpk(lo, hi);
                        }
                        *(u32x4*)(Gb + (size_t)r * D + c8) = ov;
                    }
                } else {
                    { IDS(); pg8::Gemm g{Gb, (const bf16_t*)(wts + W_COUT), D, D, D, 0}; pg8::StaticOrder So; So.init(64, 4, G, bx);
                      pg8::EpiResid E{HB, r_hb, nullptr, r_ssq, nullptr, nullptr, r_mask};
                      pg8::gemm_phase<pg8::EpiResid>(lds, g, So, E, tid); }
                    if (!dry) { IDS(); for (int task = mw; task < 64; task += NGW) meta::task_res(task, Gb, D, 0, (const bf16_t*)(wts + W_COUT), D, D, nullptr, nullptr, hmeta, HB, ssqm, lane); }
                }
            } else {
                for (int ui = vcu; ui < NB * 128 + 1; ui += G) {
                    const bool mq = ui >= NB * 128; const int b = mq ? 0 : (ui >> 7), t0 = mq ? 0 : NMETA + (ui & 127) * 64;
                    pool::unit(lds, HB, dry ? r_hb : (bf16_t*)(ws + WS_HB2), hmeta, ssq, r_ssq, ssqm, r_mask, (const bf16_t*)(wts + W_POOL), norm_mix + (size_t)2 * D, pool_scale, b, t0, mq, threadIdx.x);
                }
                __syncthreads();
            }
        }
        if (MK_N_LAUNCHES == 1 && dry) xcd_barrier(bar);
        }
        if (MK_N_LAUNCHES == 1 && ph + 1 < args.ph_hi) { xcd_barrier(bar); for (int xb = 0; xb < PROBE_XBAR; ++xb) xcd_barrier(bar); }
    }
#undef IDS
}

extern "C" void kernel_launch(void* const* d_in, const int* in_sizes, int n_in, void* d_out, int out_size, void* d_ws, size_t ws_size, hipStream_t stream) {
    static int grid = 0;
    if (grid == 0) {
        if (n_in != 19 || out_size != MR * D || ws_size < WS_END) { fprintf(stderr, "kernel_launch: unexpected shapes (n_in %d out %d ws %zu)\n", n_in, out_size, ws_size); grid = -1; return; }
        int dev = 0, cus = 0, per_cu = 0;
        if (hipGetDevice(&dev) != hipSuccess || hipDeviceGetAttribute(&cus, hipDeviceAttributeMultiprocessorCount, dev) != hipSuccess) { grid = -1; return; }
        if (hipFuncSetAttribute((const void*)mega_fwd, hipFuncAttributeMaxDynamicSharedMemorySize, LDS_BYTES) != hipSuccess) { fprintf(stderr, "kernel_launch: hipFuncSetAttribute failed\n"); grid = -1; return; }
        if (hipOccupancyMaxActiveBlocksPerMultiprocessor(&per_cu, (const void*)mega_fwd, NTHR, LDS_BYTES) != hipSuccess || per_cu < 1) { fprintf(stderr, "kernel_launch: occupancy query says %d blocks/CU\n", per_cu); }
        (void)hipGetLastError();
        grid = cus;
    }
    if (grid < 0) return;
    if (hipMemsetAsync((char*)d_ws + WS_CTL, 0, CTL_ZERO_BYTES, stream) != hipSuccess) { fprintf(stderr, "kernel_launch: memset failed\n"); return; }
    Args a{};
    for (int i = 0; i < 19; ++i) a.in[i] = (const float*)d_in[i];
    a.out = (float*)d_out; a.ws = (unsigned char*)d_ws;
    if (MK_N_LAUNCHES == 1) {
        a.ph_lo = 0; a.ph_hi = N_PHASES;
        hipLaunchKernelGGL(mega_fwd, dim3(grid), dim3(NTHR), LDS_BYTES, stream, a);
    } else {
        for (int ph = 0; ph < N_PHASES; ++ph) { a.ph_lo = ph; a.ph_hi = ph + 1; hipLaunchKernelGGL(mega_fwd, dim3(grid), dim3(NTHR), LDS_BYTES, stream, a); }
    }
}
```
